# Optimizing an MI355X kernel written in HIP

```python
import jax
import jax.numpy as jnp
from jax import lax
import numpy as np

D_MODEL = 1024
BATCH = 4
SEQ = 8192
DEPTH = 2

GRID_W = 64
CTX_LEN = 256
D_MIX = D_MODEL
HEAD_DIM = 64
ATTN_HEADS = 8
ATTN_KV_HEADS = 2
ATTN_GROUP = ATTN_HEADS // ATTN_KV_HEADS
ATTN_DIM = ATTN_HEADS * HEAD_DIM
KV_DIM = ATTN_KV_HEADS * HEAD_DIM
Q_BLOCK = 128
ROPE_THETA = 10000.0
AXIS_ROT_DIM = HEAD_DIM // 2
AXIS_FREQS = AXIS_ROT_DIM // 2
RWKV_HEADS = 8
RWKV_HEAD_DIM = 64
RWKV_DIM = RWKV_HEADS * RWKV_HEAD_DIM
DECAY_LORA = 64
ICLR_LORA = 64
GATE_LORA = 128
N_DIRS = 2
ATTN_COLS = ATTN_DIM + 2 * KV_DIM
RWKV_COLS = 3 * RWKV_DIM + N_DIRS * (DECAY_LORA + ICLR_LORA) + GATE_LORA
IN_COLS = ATTN_COLS + RWKV_COLS
SHIFT_WIDTH = 3
N_KEYS = 128
N_EXPERTS = N_KEYS * N_KEYS
PEER_HEADS = 8
PEER_KEY_DIM = 256
PEER_HALF = PEER_KEY_DIM // 2
PEER_TOPK = 16
TOKEN_BLOCK = 128
N_MOD = 6
NORM_EPS = 1e-6
GN_EPS = 64e-5
L2_EPS = 1e-12

kernel_name = 'hybrid_gqa_rwkv7_peer_dit'


def rms_norm(x, gain):
    xf = x.astype(jnp.float32)
    y = xf * lax.rsqrt(jnp.mean(xf * xf, axis=-1, keepdims=True) + NORM_EPS)
    return (y * gain.astype(jnp.float32)).astype(x.dtype)


def modulate(h, shift, scale):
    return h * (1 + scale) + shift


def axial_rope_tables(n_tokens):
    rows = n_tokens // GRID_W
    row = jnp.broadcast_to(jnp.arange(rows, dtype=jnp.float32)[:, None], (rows, GRID_W)).reshape(-1)
    col = jnp.broadcast_to(jnp.arange(GRID_W, dtype=jnp.float32)[None, :], (rows, GRID_W)).reshape(-1)
    inv_freq = ROPE_THETA ** (-jnp.arange(AXIS_FREQS, dtype=jnp.float32) * 2.0 / AXIS_ROT_DIM)
    ang = jnp.stack([row[:, None] * inv_freq, col[:, None] * inv_freq], axis=1)
    return jnp.cos(ang), jnp.sin(ang)


def apply_axial_rope(x, cos, sin):
    B, L, H, _ = x.shape
    xr = x.astype(jnp.float32).reshape(B, L, H, 2, 2, AXIS_FREQS)
    x1, x2 = xr[..., 0, :], xr[..., 1, :]
    c, s = cos[None, :, None], sin[None, :, None]
    out = jnp.stack([x1 * c - x2 * s, x2 * c + x1 * s], axis=-2)
    return out.reshape(B, L, H, HEAD_DIM).astype(x.dtype)


def block_attention(q, k, v):
    B, Lq = q.shape[:2]
    n_blk = Lq // Q_BLOCK
    qb = q.reshape(B, n_blk, Q_BLOCK, ATTN_KV_HEADS, ATTN_GROUP, HEAD_DIM).swapaxes(0, 1)
    scale = HEAD_DIM ** -0.5

    def one_block(q_blk):
        s = jnp.einsum('bqkgd,bskd->bkgqs', q_blk, k).astype(jnp.float32) * scale
        p = jax.nn.softmax(s, axis=-1).astype(v.dtype)
        return jnp.einsum('bkgqs,bskd->bqkgd', p, v)

    o = lax.map(one_block, qb)
    return o.swapaxes(0, 1).reshape(B, Lq, ATTN_DIM)


def centred_shift(x, taps):
    xp = jnp.pad(x, ((0, 0), (1, 1), (0, 0)))
    return xp[:, :-2] * taps[0] + xp[:, 1:-1] * taps[1] + xp[:, 2:] * taps[2]


def rwkv_heads(t):
    return t.reshape(t.shape[0], t.shape[1], RWKV_HEADS, RWKV_HEAD_DIM).astype(jnp.float32)


def rwkv_features(cols, shift_taps, decay_base, decay_up, iclr_base, iclr_up, gate_up, k_k, k_a):
    B, L, _ = cols.shape
    cols = centred_shift(cols, shift_taps)
    o3 = 3 * RWKV_DIM
    o4 = o3 + N_DIRS * DECAY_LORA
    o5 = o4 + N_DIRS * ICLR_LORA
    r, k, v, wd, ad, gd = jnp.split(cols, [RWKV_DIM, 2 * RWKV_DIM, o3, o4, o5], axis=-1)
    wd = jnp.tanh(wd).reshape(B, L, N_DIRS, DECAY_LORA)
    ad = ad.reshape(B, L, N_DIRS, ICLR_LORA)
    z = (decay_base + jnp.einsum('bldr,drc->bldc', wd, decay_up)).astype(jnp.float32)
    decay = jnp.exp(-jnp.exp(-jax.nn.softplus(-z) - 0.5))
    iclr = jax.nn.sigmoid((iclr_base + jnp.einsum('bldr,drc->bldc', ad, iclr_up)).astype(jnp.float32))
    gate = jax.nn.sigmoid(gd) @ gate_up
    kk = rwkv_heads(k * k_k)
    kk = kk * lax.rsqrt(jnp.sum(kk * kk, axis=-1, keepdims=True) + L2_EPS)
    k_dir = k[:, :, None, :].astype(jnp.float32) * (1 + (iclr - 1) * k_a.astype(jnp.float32))
    return r, k, v, gate, decay, iclr, kk, k_dir


def wkv_scan(r, w, k, v, kk, b, s0, reverse, emit):
    xs = tuple(jnp.moveaxis(t, 1, 0) for t in (r, w, k, v, kk, b))

    def step(state, inp):
        r_t, w_t, k_t, v_t, kk_t, b_t = inp
        s_kk = jnp.einsum('bhij,bhj->bhi', state, kk_t)
        state = state * w_t[:, :, None, :] - s_kk[..., None] * b_t[:, :, None, :] + v_t[..., None] * k_t[:, :, None, :]
        y = jnp.einsum('bhij,bhj->bhi', state, r_t) if emit else None
        return state, y

    s_final, ys = lax.scan(step, s0, xs, reverse=reverse)
    return s_final, (jnp.moveaxis(ys, 0, 1) if emit else None)


def rwkv_direction(feats, d, s0, reverse, emit):
    r, k, v, gate, decay, iclr, kk, k_dir = feats
    return wkv_scan(rwkv_heads(r), rwkv_heads(decay[:, :, d]), rwkv_heads(k_dir[:, :, d]), rwkv_heads(v),
                    kk, kk * rwkv_heads(iclr[:, :, d]), s0, reverse, emit)


def rwkv_output(y, feats, r_k, ln_w, ln_b):
    r, k, v, gate, decay, iclr, kk, k_dir = feats
    B, L = y.shape[:2]
    mu = jnp.mean(y, axis=-1, keepdims=True)
    var = jnp.mean(jnp.square(y - mu), axis=-1, keepdims=True)
    yn = ((y - mu) * lax.rsqrt(var + GN_EPS)).reshape(B, L, RWKV_DIM)
    yn = yn * ln_w.astype(jnp.float32) + ln_b.astype(jnp.float32)
    bonus = jnp.sum(rwkv_heads(r) * rwkv_heads(k) * r_k.astype(jnp.float32), axis=-1, keepdims=True) * rwkv_heads(v)
    out = (yn + bonus.reshape(B, L, RWKV_DIM)) * gate.astype(jnp.float32)
    return out.astype(r.dtype)


def rwkv_mixer(cols_lat, cols_ctx, shift_taps, decay_base, decay_up, iclr_base, iclr_up, gate_up,
               k_k, k_a, r_k, ln_w, ln_b, need_ctx_out):
    feats_lat = rwkv_features(cols_lat, shift_taps, decay_base, decay_up, iclr_base, iclr_up, gate_up, k_k, k_a)
    feats_ctx = rwkv_features(cols_ctx, shift_taps, decay_base, decay_up, iclr_base, iclr_up, gate_up, k_k, k_a)
    s0 = jnp.zeros((cols_lat.shape[0], RWKV_HEADS, RWKV_HEAD_DIM, RWKV_HEAD_DIM), jnp.float32)
    ys_lat, ys_ctx = [], []
    for d in range(N_DIRS):
        reverse = d == 1
        s_ctx, y_ctx = rwkv_direction(feats_ctx, d, s0, reverse, need_ctx_out)
        _, y_lat = rwkv_direction(feats_lat, d, s_ctx, reverse, True)
        ys_lat.append(y_lat)
        ys_ctx.append(y_ctx)
    out_lat = rwkv_output(ys_lat[0] + ys_lat[1], feats_lat, r_k, ln_w, ln_b)
    if not need_ctx_out:
        return out_lat, None
    out_ctx = rwkv_output(ys_ctx[0] + ys_ctx[1], feats_ctx, r_k, ln_w, ln_b)
    return out_lat, out_ctx


def token_mixer(h_lat, h_ctx, rope_cos, rope_sin, w_in, q_gain, k_gain, shift_taps, decay_base, decay_up,
                iclr_base, iclr_up, gate_up, k_k, k_a, r_k, ln_w, ln_b, w_out, need_ctx_out):
    p_lat = h_lat @ w_in
    p_ctx = h_ctx @ w_in

    def split_attn(p):
        B, L, _ = p.shape
        q = p[..., :ATTN_DIM].reshape(B, L, ATTN_HEADS, HEAD_DIM)
        k = p[..., ATTN_DIM:ATTN_DIM + KV_DIM].reshape(B, L, ATTN_KV_HEADS, HEAD_DIM)
        v = p[..., ATTN_DIM + KV_DIM:ATTN_COLS].reshape(B, L, ATTN_KV_HEADS, HEAD_DIM)
        return q, rms_norm(k, k_gain), v

    q_l, k_l, v_l = split_attn(p_lat)
    q_c, k_c, v_c = split_attn(p_ctx)
    q_l = apply_axial_rope(rms_norm(q_l, q_gain), rope_cos, rope_sin)
    k_l = apply_axial_rope(k_l, rope_cos, rope_sin)
    attn_lat = block_attention(q_l, jnp.concatenate([k_l, k_c], axis=1), jnp.concatenate([v_l, v_c], axis=1))
    rwkv_lat, rwkv_ctx = rwkv_mixer(p_lat[..., ATTN_COLS:], p_ctx[..., ATTN_COLS:], shift_taps, decay_base,
                                    decay_up, iclr_base, iclr_up, gate_up, k_k, k_a, r_k, ln_w, ln_b,
                                    need_ctx_out)
    out_lat = jnp.concatenate([attn_lat, rwkv_lat], axis=-1) @ w_out
    if not need_ctx_out:
        return out_lat, None
    attn_ctx = block_attention(rms_norm(q_c, q_gain), k_c, v_c)
    out_ctx = jnp.concatenate([attn_ctx, rwkv_ctx], axis=-1) @ w_out
    return out_lat, out_ctx


def peer_ffn(h, w_query, subkeys1, subkeys2, expert_u, expert_v):
    B, L, D = h.shape
    q = (h @ w_query).reshape(B, L, PEER_HEADS, 2, PEER_HALF)
    s1 = jnp.einsum('blhd,kd->blhk', q[..., 0, :], subkeys1).astype(jnp.float32)
    s2 = jnp.einsum('blhd,kd->blhk', q[..., 1, :], subkeys2).astype(jnp.float32)
    v1, i1 = lax.top_k(s1, PEER_TOPK)
    v2, i2 = lax.top_k(s2, PEER_TOPK)
    n_cand = PEER_TOPK * PEER_TOPK
    cand_score = (v1[..., :, None] + v2[..., None, :]).reshape(B, L, PEER_HEADS, n_cand)
    cand_index = (i1[..., :, None] * N_KEYS + i2[..., None, :]).reshape(B, L, PEER_HEADS, n_cand)
    top_score, top_pos = lax.top_k(cand_score, PEER_TOPK)
    expert_idx = jnp.take_along_axis(cand_index, top_pos, axis=-1)
    gates = jax.nn.softmax(top_score, axis=-1)
    n_blk = (B * L) // TOKEN_BLOCK
    hb = h.reshape(n_blk, TOKEN_BLOCK, D)
    ib = expert_idx.reshape(n_blk, TOKEN_BLOCK, PEER_HEADS * PEER_TOPK)
    gb = gates.reshape(n_blk, TOKEN_BLOCK, PEER_HEADS * PEER_TOPK)

    def one_block(args):
        h_blk, i_blk, g_blk = args
        u = jnp.take(expert_u, i_blk, axis=0)
        act = jax.nn.gelu(jnp.einsum('td,ted->te', h_blk, u).astype(jnp.float32), approximate=False)
        v = jnp.take(expert_v, i_blk, axis=0)
        return jnp.einsum('te,ted->td', (g_blk * act).astype(v.dtype), v)

    out = lax.map(one_block, (hb, ib, gb))
    return out.reshape(B, L, D)


def setup_inputs(seed: int = 0) -> dict:
    key = jax.random.key(seed)
    ks = jax.random.split(key, 28)

    def nrm(k, shape, s):
        return jax.random.normal(k, shape, jnp.float32) * s

    return {
        'x': nrm(ks[0], (BATCH, SEQ, D_MODEL), 1.0),
        'c': nrm(ks[1], (BATCH, D_MODEL), 1.0),
        'ctx': nrm(ks[2], (BATCH, CTX_LEN, D_MODEL), 1.0),
        'c_ctx': nrm(ks[3], (D_MODEL,), 1.0),
        'mod_w': nrm(ks[4], (DEPTH, D_MODEL, N_MOD * D_MODEL), 0.5 * D_MODEL ** -0.5),
        'mod_b': nrm(ks[5], (DEPTH, N_MOD * D_MODEL), 0.01),
        'norm_mix': 1.0 + nrm(ks[6], (DEPTH, D_MODEL), 0.02),
        'norm_ffn': 1.0 + nrm(ks[7], (DEPTH, D_MODEL), 0.02),
        'w_in': nrm(ks[8], (DEPTH, D_MODEL, IN_COLS), D_MODEL ** -0.5),
        'q_gain': 1.0 + nrm(ks[9], (DEPTH, HEAD_DIM), 0.02),
        'k_gain': 1.0 + nrm(ks[10], (DEPTH, HEAD_DIM), 0.02),
        'shift_taps': jnp.array([0.25, 1.0, 0.25], jnp.float32)[None, :, None]
                      + nrm(ks[11], (DEPTH, SHIFT_WIDTH, RWKV_COLS), 0.05),
        'decay_base': jax.random.uniform(ks[12], (DEPTH, N_DIRS, RWKV_DIM), jnp.float32, -6.0, 2.0),
        'decay_up': nrm(ks[13], (DEPTH, N_DIRS, DECAY_LORA, RWKV_DIM), 0.1),
        'iclr_base': nrm(ks[14], (DEPTH, N_DIRS, RWKV_DIM), 0.5),
        'iclr_up': nrm(ks[15], (DEPTH, N_DIRS, ICLR_LORA, RWKV_DIM), 0.1),
        'gate_up': nrm(ks[16], (DEPTH, GATE_LORA, RWKV_DIM), GATE_LORA ** -0.5),
        'k_k': 0.85 + nrm(ks[17], (DEPTH, RWKV_DIM), 0.05),
        'k_a': 1.0 + nrm(ks[18], (DEPTH, RWKV_DIM), 0.05),
        'r_k': nrm(ks[19], (DEPTH, RWKV_HEADS, RWKV_HEAD_DIM), 0.1),
        'ln_x_w': 1.0 + nrm(ks[20], (DEPTH, RWKV_DIM), 0.02),
        'ln_x_b': nrm(ks[21], (DEPTH, RWKV_DIM), 0.02),
        'w_out': nrm(ks[22], (DEPTH, D_MIX, D_MODEL), D_MIX ** -0.5),
        'peer_query': nrm(ks[23], (DEPTH, D_MODEL, PEER_HEADS * PEER_KEY_DIM), D_MODEL ** -0.5),
        'peer_subkeys1': nrm(ks[24], (DEPTH, N_KEYS, PEER_HALF), PEER_HALF ** -0.5),
        'peer_subkeys2': nrm(ks[25], (DEPTH, N_KEYS, PEER_HALF), PEER_HALF ** -0.5),
        'expert_u': nrm(ks[26], (DEPTH, N_EXPERTS, D_MODEL), D_MODEL ** -0.5),
        'expert_v': nrm(ks[27], (DEPTH, N_EXPERTS, D_MODEL), 0.3),
    }


def reference(x, c, ctx, c_ctx, mod_w, mod_b, norm_mix, norm_ffn, w_in, q_gain, k_gain, shift_taps,
              decay_base, decay_up, iclr_base, iclr_up, gate_up, k_k, k_a, r_k, ln_x_w, ln_x_b, w_out,
              peer_query, peer_subkeys1, peer_subkeys2, expert_u, expert_v):
    rope_cos, rope_sin = axial_rope_tables(x.shape[1])
    for l in range(DEPTH):
        need_ctx = l < DEPTH - 1
        mod_lat = jax.nn.silu(c) @ mod_w[l] + mod_b[l]
        mod_ctx = jax.nn.silu(c_ctx) @ mod_w[l] + mod_b[l]
        sh_m, sc_m, g_m, sh_f, sc_f, g_f = jnp.split(mod_lat[:, None, :], N_MOD, axis=-1)
        csh_m, csc_m, cg_m, csh_f, csc_f, cg_f = jnp.split(mod_ctx, N_MOD, axis=-1)
        h_lat = modulate(rms_norm(x, norm_mix[l]), sh_m, sc_m)
        h_ctx = modulate(rms_norm(ctx, norm_mix[l]), csh_m, csc_m)
        mix_lat, mix_ctx = token_mixer(h_lat, h_ctx, rope_cos, rope_sin, w_in[l], q_gain[l], k_gain[l],
                                       shift_taps[l], decay_base[l], decay_up[l], iclr_base[l], iclr_up[l],
                                       gate_up[l], k_k[l], k_a[l], r_k[l], ln_x_w[l], ln_x_b[l], w_out[l],
                                       need_ctx)
        x = x + g_m * mix_lat
        x = x + g_f * peer_ffn(modulate(rms_norm(x, norm_ffn[l]), sh_f, sc_f), peer_query[l],
                               peer_subkeys1[l], peer_subkeys2[l], expert_u[l], expert_v[l])
        if need_ctx:
            ctx = ctx + cg_m * mix_ctx
            ctx = ctx + cg_f * peer_ffn(modulate(rms_norm(ctx, norm_ffn[l]), csh_f, csc_f), peer_query[l],
                                        peer_subkeys1[l], peer_subkeys2[l], expert_u[l], expert_v[l])
    return x
```

```cpp
#include <hip/hip_runtime.h>
#include <hip/hip_cooperative_groups.h>
#include <stdint.h>
#include <stdio.h>

namespace cg = cooperative_groups;

typedef unsigned short bf16_t;
typedef short bf16x8 __attribute__((ext_vector_type(8)));
typedef float f32x4 __attribute__((ext_vector_type(4)));
typedef float f32x16 __attribute__((ext_vector_type(16)));
typedef unsigned u32x4 __attribute__((ext_vector_type(4)));
typedef __bf16 bf2_t __attribute__((ext_vector_type(2)));
typedef float f32x2_t __attribute__((ext_vector_type(2)));
typedef unsigned u32x6 __attribute__((ext_vector_type(6)));
typedef unsigned u32x16 __attribute__((ext_vector_type(16)));
typedef float f32x32 __attribute__((ext_vector_type(32)));
typedef __bf16 bf16x32 __attribute__((ext_vector_type(32)));
typedef unsigned u32x3 __attribute__((ext_vector_type(3)));
struct __attribute__((packed, aligned(4))) U3 { unsigned x, y, z; };

namespace {
constexpr int D = 1024, NB = 4, SEQ = 8192, CTXL = 256;
constexpr int NLAT = NB * SEQ, NCTX = NB * CTXL, NROW = NLAT + NCTX;
constexpr int LK = SEQ + CTXL;
constexpr int INC = 2688, RWC = 1920;
constexpr int NEXP = 16384;
constexpr int EROW = D * 6 / 8;
constexpr int NTHR = 256;

constexpr size_t al256(size_t x) { return (x + 255) & ~size_t(255); }
constexpr size_t SZ_E1 = size_t(NROW) * 512 * 2;
constexpr size_t OFF_WIN = 0;
constexpr size_t OFF_WOUT = OFF_WIN + al256(size_t(2) * INC * D * 2);
constexpr size_t OFF_WQB = OFF_WOUT + al256(size_t(2) * D * D * 2);
constexpr size_t OFF_SKB = OFF_WQB + al256(size_t(2) * D * 2048 * 2);
constexpr size_t OFF_WST = OFF_SKB + al256(size_t(2) * 2 * 128 * 128 * 2);
constexpr size_t OFF_MODP = OFF_WST + al256(size_t(2) * 2048 * D * 2);
constexpr size_t OFF_MOD = OFF_MODP + al256(size_t(2) * 8 * 5 * 6144 * 4);
constexpr size_t OFF_ROPE = OFF_MOD + al256(size_t(2) * 5 * 6144 * 4);
constexpr size_t OFF_CTXS = OFF_ROPE + al256(size_t(6144) * 4);
constexpr size_t OFF_BON = OFF_CTXS + al256(size_t(NCTX) * D * 4);
constexpr size_t OFF_Q = OFF_BON + al256(size_t(NROW) * 8 * 4);
constexpr size_t OFF_K = OFF_Q + al256(size_t(NB) * 8 * LK * 64 * 2);
constexpr size_t OFF_VT = OFF_K + al256(size_t(NB) * 2 * LK * 64 * 2);
constexpr size_t OFF_PR = OFF_VT + al256(size_t(NB) * 2 * LK * 64 * 2);
constexpr size_t OFF_E = OFF_PR + al256(size_t(NROW) * RWC * 2);
constexpr size_t OFF_GATE = OFF_E + al256(8 * SZ_E1);
constexpr size_t WS_END = OFF_GATE + al256(SZ_E1);
constexpr size_t OFF_LORAW = al256(WS_END + 256 + 3456 * 4);
constexpr size_t LORAW_L = 4 * 512 * 64 + 512 * 128;
constexpr size_t OFF_H = OFF_E;
constexpr size_t OFF_TOPV = OFF_E + 3 * SZ_E1;
constexpr size_t OFF_TOPI = OFF_E + 4 * SZ_E1;
constexpr size_t OFF_RWO = OFF_E + 7 * SZ_E1;
constexpr size_t OFF_Y = OFF_PR;
constexpr size_t OFF_XB = OFF_PR;
constexpr size_t OFF_AO = OFF_PR + al256(2 * SZ_E1);
static_assert(OFF_AO + size_t(NB) * 8 * LK * 64 * 2 <= OFF_E, "attention output overlaps E");
constexpr size_t OFF_EUB = OFF_E + 5 * SZ_E1;
constexpr size_t OFF_EVB = OFF_EUB + size_t(NEXP) * D;
constexpr size_t OFF_USC = OFF_EVB + size_t(NEXP) * D;
constexpr size_t OFF_VSC = OFF_USC + size_t(NEXP) * 4;
static_assert(OFF_VSC + size_t(NEXP) * 4 <= OFF_E + 7 * SZ_E1, "expert tables overlap RWO");

struct P {
    const float *x, *c, *ctx, *c_ctx, *mod_w, *mod_b, *norm_mix, *norm_ffn, *w_in, *q_gain, *k_gain, *shift_taps, *decay_base,
        *decay_up, *iclr_base, *iclr_up, *gate_up, *k_k, *k_a, *r_k, *ln_w, *ln_b, *w_out, *peer_query, *sk1, *sk2, *eu, *ev;
    float* out;
    char* ws;
};

__device__ __forceinline__ int otid() { int t = threadIdx.x; asm volatile("" : "+v"(t)); return t; }
__device__ __forceinline__ bf16_t f2bf(float f) {
    unsigned u = __float_as_uint(f);
    u += 0x7fffu + ((u >> 16) & 1u);
    return (bf16_t)(u >> 16);
}
__device__ __forceinline__ float bf2f(bf16_t h) { return __uint_as_float(((unsigned)h) << 16); }
__device__ __forceinline__ unsigned cvtpk(float lo, float hi) {
    typedef __bf16 bf2v __attribute__((ext_vector_type(2)));
    const bf2v r = {(__bf16)lo, (__bf16)hi};
    return __builtin_bit_cast(unsigned, r);
}
__device__ __forceinline__ float bflo(unsigned u) { return __uint_as_float(u << 16); }
__device__ __forceinline__ float bfhi(unsigned u) { return __uint_as_float(u & 0xffff0000u); }
__device__ __forceinline__ unsigned umed3(unsigned a, unsigned b, unsigned c) {
    unsigned r;
    asm("v_med3_u32 %0,%1,%2,%3" : "=v"(r) : "v"(a), "v"(b), "v"(c));
    return r;
}
template <int CTRL>
__device__ __forceinline__ float dppf(float v) {
    return __builtin_bit_cast(float, __builtin_amdgcn_update_dpp(0, __builtin_bit_cast(int, v), CTRL, 0xF, 0xF, true));
}
template <int CTRL>
__device__ __forceinline__ unsigned dppu(unsigned v) {
    return (unsigned)__builtin_amdgcn_update_dpp(0, (int)v, CTRL, 0xF, 0xF, true);
}
__device__ __forceinline__ float rowsum16(float p) {
    p += dppf<0xB1>(p);
    p += dppf<0x4E>(p);
    p += dppf<0x141>(p);
    p += dppf<0x140>(p);
    return p;
}
__device__ __forceinline__ float wave_sum(float v) {
#pragma unroll
    for (int o = 1; o < 64; o <<= 1) v += __shfl_xor(v, o);
    return v;
}
template <int CTRL, int RM>
__device__ __forceinline__ float dppf_rm(float v) {
    return __builtin_bit_cast(float, __builtin_amdgcn_update_dpp(0, __builtin_bit_cast(int, v), CTRL, RM, 0xF, false));
}
__device__ __forceinline__ float wave_sum_dpp(float p) {
    p = rowsum16(p);
    p += dppf_rm<0x142, 0xA>(p);
    p += dppf_rm<0x143, 0xC>(p);
    return __builtin_bit_cast(float, __builtin_amdgcn_readlane(__builtin_bit_cast(int, p), 63));
}
__device__ __forceinline__ float wave_max(float v) {
#pragma unroll
    for (int o = 1; o < 64; o <<= 1) v = fmaxf(v, __shfl_xor(v, o));
    return v;
}
__device__ __forceinline__ float sigmoidf_(float x) { return __builtin_amdgcn_rcpf(1.f + __expf(-x)); }

__device__ __forceinline__ void rowinfo(int row, int& b, int& pos, bool& isctx) {
    if (row < NLAT) { b = row >> 13; pos = row & (SEQ - 1); isctx = false; }
    else { int r = row - NLAT; b = r >> 8; pos = SEQ + (r & (CTXL - 1)); isctx = true; }
}
__device__ __forceinline__ unsigned ford(float f) { unsigned u = __float_as_uint(f); return (u & 0x80000000u) ? ~u : (u | 0x80000000u); }
__device__ __forceinline__ float funord(unsigned o) { unsigned u = (o & 0x80000000u) ? (o & 0x7fffffffu) : ~o; return __uint_as_float(u); }
__device__ __forceinline__ void ins16(unsigned (&tv)[16], unsigned key) {
#pragma unroll
    for (int j = 15; j >= 1; --j) tv[j] = umed3(tv[j - 1], tv[j], key);
    tv[0] = tv[0] > key ? tv[0] : key;
}

__device__ __forceinline__ void transpose_item(const float* __restrict__ src, int K, int N, bf16_t* __restrict__ dst, int item, float* tile) {
    const int nblk = N / 64, kb = item / nblk, nb = item % nblk, k0 = kb * 64, n0 = nb * 64, t = otid();
#pragma unroll 4
    for (int i = 0; i < 16; i++) { int kk = i * 4 + (t >> 6), nn = t & 63; tile[kk * 65 + nn] = src[(size_t)(k0 + kk) * N + n0 + nn]; }
    __syncthreads();
#pragma unroll 4
    for (int i = 0; i < 16; i++) { int nn = i * 4 + (t >> 6), kk = t & 63; dst[(size_t)(n0 + nn) * K + k0 + kk] = f2bf(tile[kk * 65 + nn]); }
    __syncthreads();
}

__device__ __forceinline__ void phase_prep(const P& p, char* smem, int bid, int nblk) {
    float* tile = (float*)smem;
    bf16_t* win = (bf16_t*)(p.ws + OFF_WIN);
    bf16_t* wout = (bf16_t*)(p.ws + OFF_WOUT);
    constexpr int I_IN = (D / 64) * (INC / 64), I_OUT = (D / 64) * (D / 64);
    bf16_t* loraw = (bf16_t*)(p.ws + OFF_LORAW);
    for (int it = bid; it < 2 * I_IN + 2 * I_OUT + 2 * 48; it += nblk) {
        int r = it;
        if (r < 2 * I_IN) { int l = r / I_IN; transpose_item(p.w_in + (size_t)l * D * INC, D, INC, win + (size_t)l * INC * D, r % I_IN, tile); continue; }
        r -= 2 * I_IN;
        if (r < 2 * I_OUT) { int l = r / I_OUT; transpose_item(p.w_out + (size_t)l * D * D, D, D, wout + (size_t)l * D * D, r % I_OUT, tile); continue; }
        r -= 2 * I_OUT;
        {
            const int l = r / 48, q = r % 48;
            bf16_t* dl = loraw + (size_t)l * LORAW_L;
            if (q < 16) transpose_item(p.decay_up + (size_t)(l * 2 + (q >> 3)) * 64 * 512, 64, 512, dl + (size_t)(q >> 3) * 32768, q & 7, tile);
            else if (q < 32) transpose_item(p.iclr_up + (size_t)(l * 2 + ((q - 16) >> 3)) * 64 * 512, 64, 512, dl + (size_t)(2 + ((q - 16) >> 3)) * 32768, q & 7, tile);
            else transpose_item(p.gate_up + (size_t)l * 128 * 512, 128, 512, dl + (size_t)4 * 32768, q - 32, tile);
        }
    }
    bf16_t* wqb = (bf16_t*)(p.ws + OFF_WQB);
    bf16_t* skb = (bf16_t*)(p.ws + OFF_SKB);
    const size_t gt = (size_t)bid * NTHR + otid(), gn = (size_t)nblk * NTHR;
    for (size_t i = gt; i < (size_t)2 * D * 2048 / 4; i += gn) {
        float4 v = ((const float4*)p.peer_query)[i];
        uint2 o; o.x = cvtpk(v.x, v.y); o.y = cvtpk(v.z, v.w);
        ((uint2*)wqb)[i] = o;
    }
    for (size_t i = gt; i < (size_t)2 * 2 * 128 * 128; i += gn) {
        int l = (int)(i / (2 * 16384)), half = (int)((i / 16384) & 1), e = (int)(i & 16383);
        const float* s = half ? p.sk2 : p.sk1;
        skb[i] = f2bf(s[(size_t)l * 16384 + e]);
    }
    float* rope = (float*)(p.ws + OFF_ROPE);
    for (size_t i = gt; i < 3072; i += gn) {
        int f = (int)(i & 15), pos = (int)(i >> 4);
        float inv = exp2f(-(float)f * (2.0f / 32.0f) * 13.287712379549449f);
        float pp = (pos < 128) ? (float)pos : (float)(pos - 128);
        float ang = pp * inv;
        float cs = cosf(ang), sn = sinf(ang);
        if (pos < 128) { rope[pos * 16 + f] = cs; rope[2048 + pos * 16 + f] = sn; }
        else { rope[4096 + (pos - 128) * 16 + f] = cs; rope[5120 + (pos - 128) * 16 + f] = sn; }
    }
    float* modp = (float*)(p.ws + OFF_MODP);
    float* sl = (float*)smem;
    for (int it = bid; it < 2 * 8 * 24; it += nblk) {
        int l = it / (8 * 24), kc = (it / 24) & 7, nb = it % 24;
        __syncthreads();
        for (int i = otid(); i < 5 * 128; i += NTHR) {
            int s = i >> 7, k = kc * 128 + (i & 127);
            float cv = (s < 4) ? p.c[s * D + k] : p.c_ctx[k];
            sl[i] = cv / (1.f + __expf(-cv));
        }
        __syncthreads();
        int n = nb * 256 + otid();
        float a0 = 0, a1 = 0, a2 = 0, a3 = 0, a4 = 0;
        const float* w = p.mod_w + ((size_t)l * D + kc * 128) * 6144 + n;
#pragma unroll 8
        for (int k = 0; k < 128; k++) {
            float wv = w[(size_t)k * 6144];
            a0 += sl[k] * wv; a1 += sl[128 + k] * wv; a2 += sl[256 + k] * wv; a3 += sl[384 + k] * wv; a4 += sl[512 + k] * wv;
        }
        float* o = modp + ((size_t)(l * 8 + kc) * 5) * 6144 + n;
        o[0] = a0; o[6144] = a1; o[2 * 6144] = a2; o[3 * 6144] = a3; o[4 * 6144] = a4;
    }
}

__device__ __forceinline__ void phase_prep2(const P& p, int bid, int nblk) {
    const float* modp = (const float*)(p.ws + OFF_MODP);
    float* mod = (float*)(p.ws + OFF_MOD);
    for (int i = bid * NTHR + otid(); i < 2 * 5 * 6144; i += nblk * NTHR) {
        int l = i / (5 * 6144), r = i % (5 * 6144), n = r % 6144;
        float a = p.mod_b[l * 6144 + n];
#pragma unroll
        for (int kc = 0; kc < 8; kc++) a += modp[(size_t)(l * 8 + kc) * 5 * 6144 + r];
        mod[i] = a;
    }
}

template <bool LATBF>
__device__ __forceinline__ void phase_normmod(const float* xlat, const float* xctx, const float* gain, const float* mod, int shi, int sci, bf16_t* H,
                              int nrows, int bid, int nblk) {
    const int lane = otid() & 63, gw = bid * 4 + (otid() >> 6), nw = nblk * 4;
    for (int row = gw; row < nrows; row += nw) {
        int b, pos; bool isctx; rowinfo(row, b, pos, isctx);
        const int s = isctx ? 4 : b;
        const float* src = isctx ? xctx + (size_t)(row - NLAT) * D : xlat + (size_t)row * D;
        float4 v[4]; float ss = 0.f;
        if (LATBF && !isctx) {
            const uint2* sb = (const uint2*)((const bf16_t*)xlat + (size_t)row * D);
#pragma unroll
            for (int j = 0; j < 4; j++) { const uint2 u = sb[j * 64 + lane]; v[j] = make_float4(bflo(u.x), bfhi(u.x), bflo(u.y), bfhi(u.y)); }
        } else {
#pragma unroll
            for (int j = 0; j < 4; j++) v[j] = ((const float4*)src)[j * 64 + lane];
        }
#pragma unroll
        for (int j = 0; j < 4; j++) ss += v[j].x * v[j].x + v[j].y * v[j].y + v[j].z * v[j].z + v[j].w * v[j].w;
        ss = wave_sum(ss);
        const float rinv = rsqrtf(ss * (1.f / D) + 1e-6f);
        const float* sh = mod + s * 6144 + shi * 1024; const float* sc = mod + s * 6144 + sci * 1024;
#pragma unroll
        for (int j = 0; j < 4; j++) {
            int idx = j * 64 + lane;
            float4 g = ((const float4*)gain)[idx], a = ((const float4*)sc)[idx], c = ((const float4*)sh)[idx];
            float h0 = v[j].x * rinv * g.x * (1.f + a.x) + c.x, h1 = v[j].y * rinv * g.y * (1.f + a.y) + c.y;
            float h2 = v[j].z * rinv * g.z * (1.f + a.z) + c.z, h3 = v[j].w * rinv * g.w * (1.f + a.w) + c.w;
            uint2 o; o.x = cvtpk(h0, h1); o.y = cvtpk(h2, h3);
            ((uint2*)(H + (size_t)row * D))[idx] = o;
        }
    }
}

constexpr int LDT = 72;
constexpr int CSLD = 132;
constexpr int GEMM_SMEM = 2 * 2 * 128 * LDT * 2;

struct ARow { const bf16_t* A; int lda; __device__ __forceinline__ const bf16_t* operator()(int row, int k) const { return A + (size_t)row * lda + k; } };
struct AMix {
    const bf16_t* Q; const bf16_t* R;
    __device__ __forceinline__ const bf16_t* operator()(int row, int k) const {
        if (k < 512) { int b, pos; bool c; rowinfo(row, b, pos, c); return Q + ((size_t)((b * 8 + (k >> 6)) * LK + pos)) * 64 + (k & 63); }
        return R + (size_t)row * 512 + (k - 512);
    }
};

#define GAS __attribute__((address_space(1)))
#define LDSAS __attribute__((address_space(3)))
template <class AP, class EPI>
__device__ __forceinline__ void gemm_tile(const AP& ap, const bf16_t* __restrict__ Bt, int ldb, int K, int m0, int n0, char* smem, const EPI& epi) {
    const bf16_t* As = (const bf16_t*)smem;
    const bf16_t* Bs = As + 2 * 128 * 64;
    const int tid = otid(), lane = tid & 63, wid = tid >> 6, wr = wid >> 1, wc = wid & 1;
    const int wu = __builtin_amdgcn_readfirstlane(wid);
    f32x4 acc[4][4];
#pragma unroll
    for (int i = 0; i < 4; i++)
#pragma unroll
        for (int j = 0; j < 4; j++) acc[i][j] = f32x4{0.f, 0.f, 0.f, 0.f};
    auto stage = [&](int buf, int k0) {
#pragma unroll
        for (int i = 0; i < 4; i++) {
            const int piece = wu * 4 + i, row = piece * 8 + (lane >> 3), kc = (lane & 7) ^ ((row >> 1) & 7);
            __builtin_amdgcn_global_load_lds((const GAS void*)ap(m0 + row, k0 + kc * 8), (LDSAS void*)(smem + buf * 16384 + piece * 1024), 16, 0, 0);
            __builtin_amdgcn_global_load_lds((const GAS void*)(Bt + (size_t)(n0 + row) * ldb + k0 + kc * 8), (LDSAS void*)(smem + 32768 + buf * 16384 + piece * 1024), 16, 0, 0);
        }
    };
    stage(0, 0);
    __syncthreads();
    const int nk = K / 64;
    for (int kt = 0; kt < nk; kt++) {
        const int cur = kt & 1;
        if (kt + 1 < nk) stage(cur ^ 1, (kt + 1) * 64);
#pragma unroll
        for (int ks = 0; ks < 2; ks++) {
            const int kch = ks * 4 + (lane >> 4);
            bf16x8 af[4], bfr[4];
#pragma unroll
            for (int mi = 0; mi < 4; mi++) { const int row = wr * 64 + mi * 16 + (lane & 15); af[mi] = *(const bf16x8*)(As + cur * 8192 + row * 64 + ((kch ^ ((row >> 1) & 7)) << 3)); }
#pragma unroll
            for (int ni = 0; ni < 4; ni++) { const int row = wc * 64 + ni * 16 + (lane & 15); bfr[ni] = *(const bf16x8*)(Bs + cur * 8192 + row * 64 + ((kch ^ ((row >> 1) & 7)) << 3)); }
#pragma unroll
            for (int mi = 0; mi < 4; mi++)
#pragma unroll
                for (int ni = 0; ni < 4; ni++) acc[mi][ni] = __builtin_amdgcn_mfma_f32_16x16x32_bf16(af[mi], bfr[ni], acc[mi][ni], 0, 0, 0);
        }
        __syncthreads();
    }
    float* Cs = (float*)smem;
#pragma unroll
    for (int mi = 0; mi < 4; mi++)
#pragma unroll
        for (int ni = 0; ni < 4; ni++)
#pragma unroll
            for (int j = 0; j < 4; j++) Cs[(wr * 64 + mi * 16 + (lane >> 4) * 4 + j) * CSLD + wc * 64 + ni * 16 + (lane & 15)] = acc[mi][ni][j];
    __syncthreads();
    epi(Cs, m0, n0);
    __syncthreads();
}

__device__ __forceinline__ void store8bf(bf16_t* dst, const float* v) {
    uint4 o; o.x = cvtpk(v[0], v[1]); o.y = cvtpk(v[2], v[3]); o.z = cvtpk(v[4], v[5]); o.w = cvtpk(v[6], v[7]);
    *(uint4*)dst = o;
}

struct EpiInProj {
    bf16_t *Q, *K, *VT, *PR; const float *qg, *kg, *rope;
    __device__ __forceinline__ void operator()(const float* Cs, int m0, int n0) const {
        const int t = otid(), nt = n0 >> 7;
        int b, pos0; bool isctx; rowinfo(m0, b, pos0, isctx);
        if (nt <= 4) {
            const int r = t & 127, hh = t >> 7;
            const float* src = Cs + r * CSLD + hh * 64;
            float v[64]; float ss = 0.f;
#pragma unroll
            for (int i = 0; i < 16; i++) { float4 f = *(const float4*)(src + 4 * i); v[4 * i] = f.x; v[4 * i + 1] = f.y; v[4 * i + 2] = f.z; v[4 * i + 3] = f.w; ss += f.x * f.x + f.y * f.y + f.z * f.z + f.w * f.w; }
            const float rinv = rsqrtf(ss * (1.f / 64.f) + 1e-6f);
            const float* g = (nt == 4) ? kg : qg;
            const float qs = (nt == 4) ? 1.f : 0.125f * 1.4426950408889634f;
#pragma unroll
            for (int d = 0; d < 64; d++) v[d] = v[d] * (rinv * qs) * g[d];
            if (!isctx) {
                const int tp = pos0 + r, prow = tp >> 6, pcol = tp & 63;
                const float *cr = rope + prow * 16, *sr = rope + 2048 + prow * 16, *cc = rope + 4096 + pcol * 16, *sc = rope + 5120 + pcol * 16;
#pragma unroll
                for (int f = 0; f < 16; f++) {
                    float c = cr[f], s = sr[f], x1 = v[f], x2 = v[16 + f];
                    v[f] = x1 * c - x2 * s; v[16 + f] = x2 * c + x1 * s;
                    c = cc[f]; s = sc[f]; x1 = v[32 + f]; x2 = v[48 + f];
                    v[32 + f] = x1 * c - x2 * s; v[48 + f] = x2 * c + x1 * s;
                }
            }
            bf16_t* dst = (nt == 4) ? K + ((size_t)((b * 2 + hh) * LK + pos0 + r)) * 64 : Q + ((size_t)((b * 8 + nt * 2 + hh) * LK + pos0 + r)) * 64;
#pragma unroll
            for (int i = 0; i < 8; i++) store8bf(dst + 8 * i, v + 8 * i);
        } else if (nt == 5) {
            const int c = t >> 1, half = t & 1, kvh = c >> 6, d = c & 63;
            bf16_t* dst = VT + ((size_t)((b * 2 + kvh) * 64 + d)) * LK + pos0 + half * 64;
#pragma unroll
            for (int i = 0; i < 8; i++) {
                float v[8];
#pragma unroll
                for (int j = 0; j < 8; j++) v[j] = Cs[(half * 64 + (i >> 1) * 16 + (i & 1) * 4 + (j & 3) + 8 * (j >> 2)) * CSLD + c];
                store8bf(dst + 8 * i, v);
            }
        } else {
            const int r = t >> 1, half = t & 1;
            const float* src = Cs + r * CSLD + half * 64;
            bf16_t* dst = PR + (size_t)(m0 + r) * RWC + (nt - 6) * 128 + half * 64;
#pragma unroll
            for (int i = 0; i < 8; i++) {
                float4 f0 = *(const float4*)(src + 8 * i), f1 = *(const float4*)(src + 8 * i + 4);
                float v[8] = {f0.x, f0.y, f0.z, f0.w, f1.x, f1.y, f1.z, f1.w};
                store8bf(dst + 8 * i, v);
            }
        }
    }
};

struct EpiOutProj {
    const float *xlat, *xctx; bf16_t* olat; float* octx; const float* gm;
    __device__ __forceinline__ void operator()(const float* Cs, int m0, int n0) const {
        const int t = otid();
        int b, pos0; bool isctx; rowinfo(m0, b, pos0, isctx);
        const int s = isctx ? 4 : b;
        const float* g = gm + s * 6144 + n0;
        const float* xin = isctx ? xctx + (size_t)(m0 - NLAT) * D : xlat + (size_t)m0 * D;
        if (isctx) {
            float* xo = octx + (size_t)(m0 - NLAT) * D;
#pragma unroll 4
            for (int i = 0; i < 16; i++) {
                int f4 = t + 256 * i, r = f4 >> 5, c4 = (f4 & 31) * 4;
                float4 a = *(const float4*)(Cs + r * CSLD + c4);
                float4 x = *(const float4*)(xin + (size_t)r * D + n0 + c4);
                float4 gg = *(const float4*)(g + c4);
                float4 o; o.x = x.x + gg.x * a.x; o.y = x.y + gg.y * a.y; o.z = x.z + gg.z * a.z; o.w = x.w + gg.w * a.w;
                *(float4*)(xo + (size_t)r * D + n0 + c4) = o;
            }
        } else {
            bf16_t* xo = olat + (size_t)m0 * D;
#pragma unroll 4
            for (int i = 0; i < 16; i++) {
                int f4 = t + 256 * i, r = f4 >> 5, c4 = (f4 & 31) * 4;
                float4 a = *(const float4*)(Cs + r * CSLD + c4);
                float4 x = *(const float4*)(xin + (size_t)r * D + n0 + c4);
                float4 gg = *(const float4*)(g + c4);
                uint2 o; o.x = cvtpk(x.x + gg.x * a.x, x.y + gg.y * a.y); o.y = cvtpk(x.z + gg.z * a.z, x.w + gg.w * a.w);
                *(uint2*)(xo + (size_t)r * D + n0 + c4) = o;
            }
        }
    }
};

struct EpiStoreBf {
    bf16_t* C; int ldc;
    __device__ __forceinline__ void operator()(const float* Cs, int m0, int n0) const {
        const int t = otid(), r = t >> 1, half = t & 1;
        const float* src = Cs + r * CSLD + half * 64;
        bf16_t* dst = C + (size_t)(m0 + r) * ldc + n0 + half * 64;
#pragma unroll
        for (int i = 0; i < 8; i++) {
            float4 f0 = *(const float4*)(src + 8 * i), f1 = *(const float4*)(src + 8 * i + 4);
            float v[8] = {f0.x, f0.y, f0.z, f0.w, f1.x, f1.y, f1.z, f1.w};
            store8bf(dst + 8 * i, v);
        }
    }
};

struct EpiTopk {
    float* TV; int* TI;
    __device__ __forceinline__ void operator()(const float* Cs, int m0, int n0) const {
        const int t = otid(), r = t >> 1, half = t & 1, slice = n0 >> 7;
        const float* src = Cs + r * CSLD + half * 64;
        unsigned top[16];
#pragma unroll
        for (int j = 0; j < 16; j++) top[j] = 0u;
#pragma unroll
        for (int i = 0; i < 16; i++) {
            float4 f = *(const float4*)(src + 4 * i);
            const unsigned base = 127u - (unsigned)(half * 64 + 4 * i);
            ins16(top, (ford(f.x) & 0xFFFFFF80u) | (base));
            ins16(top, (ford(f.y) & 0xFFFFFF80u) | (base - 1));
            ins16(top, (ford(f.z) & 0xFFFFFF80u) | (base - 2));
            ins16(top, (ford(f.w) & 0xFFFFFF80u) | (base - 3));
        }
        asm volatile("s_nop 1" : "+v"(top[0]), "+v"(top[1]), "+v"(top[2]), "+v"(top[3]), "+v"(top[4]), "+v"(top[5]), "+v"(top[6]), "+v"(top[7]),
                                 "+v"(top[8]), "+v"(top[9]), "+v"(top[10]), "+v"(top[11]), "+v"(top[12]), "+v"(top[13]), "+v"(top[14]), "+v"(top[15]));
        unsigned oth[16];
#pragma unroll
        for (int j = 0; j < 16; j++) oth[j] = dppu<0xB1>(top[j]);
#pragma unroll
        for (int j = 0; j < 16; j++) ins16(top, oth[j]);
        const size_t o = ((size_t)(m0 + r) * 16 + slice) * 16;
        if (half == 0) {
#pragma unroll
            for (int j = 0; j < 4; j++) { float4 f; f.x = funord(top[4 * j] & 0xFFFFFF80u); f.y = funord(top[4 * j + 1] & 0xFFFFFF80u); f.z = funord(top[4 * j + 2] & 0xFFFFFF80u); f.w = funord(top[4 * j + 3] & 0xFFFFFF80u); *(float4*)(TV + o + 4 * j) = f; }
        } else {
#pragma unroll
            for (int j = 0; j < 4; j++) { int4 f; f.x = 127 - (int)(top[4 * j] & 127u); f.y = 127 - (int)(top[4 * j + 1] & 127u); f.z = 127 - (int)(top[4 * j + 2] & 127u); f.w = 127 - (int)(top[4 * j + 3] & 127u); *(int4*)(TI + o + 4 * j) = f; }
        }
    }
};

__device__ __forceinline__ void phase_ws(const P& p, char* smem, int bid, int nblk) {
    const bf16_t* wqb = (const bf16_t*)(p.ws + OFF_WQB);
    const bf16_t* skb = (const bf16_t*)(p.ws + OFF_SKB);
    bf16_t* wst = (bf16_t*)(p.ws + OFF_WST);
    for (int it = bid; it < 2 * 16 * 8; it += nblk) {
        const int l = it >> 7, slice = (it >> 3) & 15, nt = it & 7, half = slice & 1;
        ARow ap{skb + (size_t)(l * 2 + half) * 16384, 128};
        EpiStoreBf epi{wst + (size_t)l * 2048 * D + (size_t)slice * 128 * D, D};
        gemm_tile(ap, wqb + (size_t)l * D * 2048 + slice * 128, 2048, 128, 0, nt * 128, smem, epi);
    }
}

__device__ __forceinline__ int xcd_vbid(int bid, int nblk) { return ((nblk & 7) == 0) ? (bid & 7) * (nblk >> 3) + (bid >> 3) : bid; }
__device__ __forceinline__ void phase_inproj(const P& p, int l, char* smem, int bid, int nblk) {
    ARow ap{(const bf16_t*)(p.ws + OFF_H), D};
    EpiInProj epi{(bf16_t*)(p.ws + OFF_Q), (bf16_t*)(p.ws + OFF_K), (bf16_t*)(p.ws + OFF_VT), (bf16_t*)(p.ws + OFF_PR),
                  p.q_gain + l * 64, p.k_gain + l * 64, (const float*)(p.ws + OFF_ROPE)};
    const bf16_t* Bt = (const bf16_t*)(p.ws + OFF_WIN) + (size_t)l * INC * D;
    constexpr int NT = INC / 128, MT = NROW / 128;
    static_assert(MT % 8 == 0, "");
    for (int it = xcd_vbid(bid, nblk); it < MT * NT; it += nblk) {
        const int g = it / (8 * NT), r = it % (8 * NT), nt = r >> 3, mt = g * 8 + (r & 7);
        gemm_tile(ap, Bt, D, D, mt * 128, nt * 128, smem, epi);
    }
}

__device__ __forceinline__ void unpack8(const uint4 u, float* v) {
    v[0] = bflo(u.x); v[1] = bfhi(u.x); v[2] = bflo(u.y); v[3] = bfhi(u.y); v[4] = bflo(u.z); v[5] = bfhi(u.z); v[6] = bflo(u.w); v[7] = bfhi(u.w);
}
__device__ __forceinline__ float sum8(float p) {
    p += dppf<0xB1>(p); p += dppf<0x4E>(p); p += dppf<0x141>(p);
    return p;
}
__device__ __forceinline__ void phase_features_shift(const P& p, int l, unsigned* ctr) {
    const bf16_t* PR = (const bf16_t*)(p.ws + OFF_PR);
    bf16_t* E = (bf16_t*)(p.ws + OFF_E);
    float* BON = (float*)(p.ws + OFF_BON);
    const float* taps = p.shift_taps + (size_t)l * 3 * RWC;
    const size_t ES = SZ_E1 / 2;
    const int tid = otid(), lane = tid & 63, c0 = lane * 8;
    float tp[3][3][8], kkw[8], rkw[8];
#pragma unroll
    for (int a = 0; a < 3; a++)
#pragma unroll
        for (int t = 0; t < 3; t++)
#pragma unroll
            for (int j = 0; j < 8; j++) tp[a][t][j] = taps[t * RWC + a * 512 + c0 + j];
#pragma unroll
    for (int j = 0; j < 8; j++) { kkw[j] = p.k_k[l * 512 + c0 + j]; rkw[j] = p.r_k[l * 512 + c0 + j]; }
    for (;;) {
        unsigned gq = 0u;
        if (lane == 0) gq = atomicAdd(ctr, 1u);
        const int g = __builtin_amdgcn_readfirstlane((int)gq);
        if (g >= NROW / 8) break;
        const int r0 = g * 8;
        const bool isctx = r0 >= NLAT;
        const int tt0 = isctx ? ((r0 - NLAT) & (CTXL - 1)) : (r0 & (SEQ - 1));
        const int L = isctx ? CTXL : SEQ;
        float pv[3][8], cu[3][8], nx[3][8];
#pragma unroll
        for (int a = 0; a < 3; a++) {
            if (tt0 > 0) unpack8(*(const uint4*)(PR + (size_t)(r0 - 1) * RWC + a * 512 + c0), pv[a]);
            else {
#pragma unroll
                for (int j = 0; j < 8; j++) pv[a][j] = 0.f;
            }
            unpack8(*(const uint4*)(PR + (size_t)r0 * RWC + a * 512 + c0), cu[a]);
        }
#pragma unroll
        for (int tok = 0; tok < 8; tok++) {
            const int row = r0 + tok;
#pragma unroll
            for (int a = 0; a < 3; a++) {
                if (tt0 + tok < L - 1) unpack8(*(const uint4*)(PR + (size_t)(row + 1) * RWC + a * 512 + c0), nx[a]);
                else {
#pragma unroll
                    for (int j = 0; j < 8; j++) nx[a][j] = 0.f;
                }
            }
            float rr[8], kk_[8], vv[8], kraw[8]; float ssq = 0.f, bon = 0.f;
#pragma unroll
            for (int j = 0; j < 8; j++) {
                rr[j] = pv[0][j] * tp[0][0][j] + cu[0][j] * tp[0][1][j] + nx[0][j] * tp[0][2][j];
                kk_[j] = pv[1][j] * tp[1][0][j] + cu[1][j] * tp[1][1][j] + nx[1][j] * tp[1][2][j];
                vv[j] = pv[2][j] * tp[2][0][j] + cu[2][j] * tp[2][1][j] + nx[2][j] * tp[2][2][j];
                kraw[j] = kk_[j] * kkw[j]; ssq += kraw[j] * kraw[j]; bon += rr[j] * kk_[j] * rkw[j];
            }
            ssq = sum8(ssq); bon = sum8(bon);
            const float rn = rsqrtf(ssq + 1e-12f);
#pragma unroll
            for (int j = 0; j < 8; j++) kraw[j] *= rn;
            const size_t o = (size_t)row * 512 + c0;
            store8bf(E + o, rr); store8bf(E + ES + o, kk_); store8bf(E + 2 * ES + o, vv); store8bf(E + 3 * ES + o, kraw);
            if ((lane & 7) == 0) BON[(size_t)row * 8 + (lane >> 3)] = bon;
#pragma unroll
            for (int a = 0; a < 3; a++)
#pragma unroll
                for (int j = 0; j < 8; j++) { pv[a][j] = cu[a][j]; cu[a][j] = nx[a][j]; }
        }
    }
}

template <int K>
__device__ __forceinline__ void lora_item(const P& p, int l, int mt, int type, char* smem) {
    constexpr int KP = K + 8;
    bf16_t* As = (bf16_t*)smem;
    bf16_t* Bs = As + 128 * KP;
    const bf16_t* PR = (const bf16_t*)(p.ws + OFF_PR);
    const float* taps = p.shift_taps + (size_t)l * 3 * RWC;
    const int tid = otid(), lane = tid & 63, wid = tid >> 6, wr = wid >> 1, wc = wid & 1;
    const int m0 = mt * 128;
    const int colbase = 1536 + (type < 4 ? type * 64 : 256);
    __syncthreads();
    {
        const int r = tid >> 1, half = tid & 1, row = m0 + r;
        const bool isctx = row >= NLAT;
        const int tt = isctx ? ((row - NLAT) & (CTXL - 1)) : (row & (SEQ - 1));
        const int L = isctx ? CTXL : SEQ;
        const bool hp = tt > 0, hn = tt < L - 1;
#pragma unroll
        for (int g = 0; g < K / 16; g++) {
            const int cl = half * (K / 2) + g * 8, col = colbase + cl;
            float a[8], b[8], c[8], v[8];
            unpack8(*(const uint4*)(PR + (size_t)row * RWC + col), b);
            if (hp) unpack8(*(const uint4*)(PR + (size_t)(row - 1) * RWC + col), a);
            if (hn) unpack8(*(const uint4*)(PR + (size_t)(row + 1) * RWC + col), c);
#pragma unroll
            for (int j = 0; j < 8; j++) {
                float x = b[j] * taps[RWC + col + j];
                if (hp) x += a[j] * taps[col + j];
                if (hn) x += c[j] * taps[2 * RWC + col + j];
                if (type < 2) x = 1.f - 2.f * __builtin_amdgcn_rcpf(1.f + __expf(2.f * x));
                else if (type == 4) x = sigmoidf_(x);
                v[j] = x;
            }
            store8bf(As + r * KP + cl, v);
        }
    }
    const bf16_t* Bt = (const bf16_t*)(p.ws + OFF_LORAW) + (size_t)l * LORAW_L + (size_t)(type < 4 ? type * 32768 : 4 * 32768);
    bf16_t* dst;
    {
        bf16_t* E = (bf16_t*)(p.ws + OFF_E);
        const size_t ES = SZ_E1 / 2;
        dst = (type < 2) ? E + (4 + type) * ES : (type < 4) ? E + (6 + type - 2) * ES : (bf16_t*)(p.ws + OFF_GATE);
    }
    const float* base = (type < 2) ? p.decay_base + (l * 2 + type) * 512 : (type < 4) ? p.iclr_base + (l * 2 + type - 2) * 512 : nullptr;
    const int bo0 = (tid / (K / 8)) * K + (tid % (K / 8)) * 8, bo1 = ((tid + 256) / (K / 8)) * K + ((tid + 256) % (K / 8)) * 8;
    const int bo2 = ((tid + 512) / (K / 8)) * K + ((tid + 512) % (K / 8)) * 8, bo3 = ((tid + 768) / (K / 8)) * K + ((tid + 768) % (K / 8)) * 8;
    const int bl0 = (tid / (K / 8)) * KP + (tid % (K / 8)) * 8, bl1 = ((tid + 256) / (K / 8)) * KP + ((tid + 256) % (K / 8)) * 8;
    const int bl2 = ((tid + 512) / (K / 8)) * KP + ((tid + 512) % (K / 8)) * 8, bl3 = ((tid + 768) / (K / 8)) * KP + ((tid + 768) % (K / 8)) * 8;
    uint4 bp0 = *(const uint4*)(Bt + bo0), bp1 = *(const uint4*)(Bt + bo1), bp2 = bp0, bp3 = bp0;
    if (K == 128) { bp2 = *(const uint4*)(Bt + bo2); bp3 = *(const uint4*)(Bt + bo3); }
#pragma unroll 1
    for (int nt = 0; nt < 8; nt++) {
        __syncthreads();
        *(uint4*)(Bs + bl0) = bp0; *(uint4*)(Bs + bl1) = bp1;
        if (K == 128) { *(uint4*)(Bs + bl2) = bp2; *(uint4*)(Bs + bl3) = bp3; }
        {
            const bf16_t* bn = Bt + (size_t)(nt < 7 ? nt + 1 : 7) * 64 * K;
            bp0 = *(const uint4*)(bn + bo0); bp1 = *(const uint4*)(bn + bo1);
            if (K == 128) { bp2 = *(const uint4*)(bn + bo2); bp3 = *(const uint4*)(bn + bo3); }
        }
        __syncthreads();
        f32x4 acc[4][2];
#pragma unroll
        for (int i = 0; i < 4; i++)
#pragma unroll
            for (int j = 0; j < 2; j++) acc[i][j] = f32x4{0.f, 0.f, 0.f, 0.f};
#pragma unroll
        for (int ks = 0; ks < K / 32; ks++) {
            bf16x8 af[4], bfr[2];
#pragma unroll
            for (int mi = 0; mi < 4; mi++) af[mi] = *(const bf16x8*)(As + (wr * 64 + mi * 16 + (lane & 15)) * KP + ks * 32 + (lane >> 4) * 8);
#pragma unroll
            for (int ni = 0; ni < 2; ni++) bfr[ni] = *(const bf16x8*)(Bs + (wc * 32 + ni * 16 + (lane & 15)) * KP + ks * 32 + (lane >> 4) * 8);
#pragma unroll
            for (int mi = 0; mi < 4; mi++)
#pragma unroll
                for (int ni = 0; ni < 2; ni++) acc[mi][ni] = __builtin_amdgcn_mfma_f32_16x16x32_bf16(bfr[ni], af[mi], acc[mi][ni], 0, 0, 0);
        }
#pragma unroll
        for (int ni = 0; ni < 2; ni++) {
            const int col = nt * 64 + wc * 32 + ni * 16 + (lane >> 4) * 4;
            float4 bs = make_float4(0.f, 0.f, 0.f, 0.f);
            if (type < 4) bs = *(const float4*)(base + col);
            const float bsv[4] = {bs.x, bs.y, bs.z, bs.w};
#pragma unroll
            for (int mi = 0; mi < 4; mi++) {
                const int row = m0 + wr * 64 + mi * 16 + (lane & 15);
                float v[4];
#pragma unroll
                for (int j = 0; j < 4; j++) {
                    v[j] = acc[mi][ni][j] + bsv[j];
                    if (type < 2) v[j] = 0.60653065971f * sigmoidf_(v[j]);
                    else if (type < 4) v[j] = sigmoidf_(v[j]);
                }
                uint2 o; o.x = cvtpk(v[0], v[1]); o.y = cvtpk(v[2], v[3]);
                *(uint2*)(dst + (size_t)row * 512 + col) = o;
            }
        }
    }
}

__device__ __forceinline__ void phase_features(const P& p, int l, char* smem, int bid, int nblk, unsigned* ctr) {
    for (int it = bid; it < (NROW / 128) * 5; it += nblk) {
        const int mt = it / 5, type = it % 5;
        if (type == 4) lora_item<128>(p, l, mt, 4, smem);
        else lora_item<64>(p, l, mt, type, smem);
    }
    phase_features_shift(p, l, ctr);
}

constexpr int SCH = 16;
constexpr int SROW = 336;
constexpr int SCAN_SMEM = 2 * SCH * SROW * 4 + 2 * SCH * 16 * 4;

__device__ __forceinline__ void scan_item(const P& p, int l, int item, bool need_ctx_out, char* smem) {
    float* buf = (float*)smem;
    float* ybuf = buf + 2 * SCH * SROW;
    const bf16_t* E = (const bf16_t*)(p.ws + OFF_E);
    bf16_t* Y = (bf16_t*)(p.ws + OFF_Y);
    const int sc = item >> 2, rb = item & 3, b = sc >> 4, h = (sc >> 1) & 7, d = sc & 1, i0 = rb * 16;
    const int tid = otid(), lane = tid & 63, wid = tid >> 6, cg4 = (lane & 15) * 4, lr = wid * 4 + (lane >> 4);
    const int st_s = tid >> 4, c4_s = (tid & 15) * 4;
    const size_t ES = SZ_E1 / 2;
    float ka[4];
#pragma unroll
    for (int q = 0; q < 4; q++) ka[q] = p.k_a[l * 512 + h * 64 + c4_s + q];
    auto row_of = [&](int tau) -> int {
        if (tau < CTXL) { int t = d ? (CTXL - 1 - tau) : tau; return NLAT + b * CTXL + t; }
        int t = tau - CTXL; t = d ? (SEQ - 1 - t) : t; return b * SEQ + t;
    };
    struct SSet { uint2 r, k, kk, lw, ic, v; };
    SSet sA, sB;
    const char* Eb = (const char*)E;
    const int sdir = d ? -1 : 1;
    auto gload = [&](SSet& g, int ch) {
        uint2 &g_r = g.r, &g_k = g.k, &g_kk = g.kk, &g_lw = g.lw, &g_ic = g.ic, &g_v = g.v;
        const int rbase = row_of(ch * SCH);
        const unsigned voff = (unsigned)(rbase + sdir * st_s) * 1024u + (unsigned)(h * 64 + c4_s) * 2u;
        g_r = *(const uint2*)(Eb + voff); g_k = *(const uint2*)(Eb + ES * 2 + voff); g_kk = *(const uint2*)(Eb + 3 * ES * 2 + voff);
        g_lw = *(const uint2*)(Eb + (size_t)(4 + d) * ES * 2 + voff); g_ic = *(const uint2*)(Eb + (size_t)(6 + d) * ES * 2 + voff);
        { const int t6 = tid & 63; const unsigned voff2 = (unsigned)(rbase + sdir * (t6 >> 2)) * 1024u + (unsigned)(h * 64 + i0 + (t6 & 3) * 4) * 2u; g_v = *(const uint2*)(Eb + 2 * ES * 2 + voff2); }
    };
    auto swrite = [&](const SSet& g, int nb) {
        const uint2 g_r = g.r, g_k = g.k, g_kk = g.kk, g_lw = g.lw, g_ic = g.ic, g_v = g.v;
        float* dst = buf + (nb * SCH + st_s) * SROW + c4_s;
        float r_[4] = {bflo(g_r.x), bfhi(g_r.x), bflo(g_r.y), bfhi(g_r.y)};
        float k_[4] = {bflo(g_k.x), bfhi(g_k.x), bflo(g_k.y), bfhi(g_k.y)};
        float kk_[4] = {bflo(g_kk.x), bfhi(g_kk.x), bflo(g_kk.y), bfhi(g_kk.y)};
        float lw_[4] = {bflo(g_lw.x), bfhi(g_lw.x), bflo(g_lw.y), bfhi(g_lw.y)};
        float ic_[4] = {bflo(g_ic.x), bfhi(g_ic.x), bflo(g_ic.y), bfhi(g_ic.y)};
        float4 w4, b4, kd4;
        w4.x = __expf(-lw_[0]); w4.y = __expf(-lw_[1]); w4.z = __expf(-lw_[2]); w4.w = __expf(-lw_[3]);
        b4.x = kk_[0] * ic_[0]; b4.y = kk_[1] * ic_[1]; b4.z = kk_[2] * ic_[2]; b4.w = kk_[3] * ic_[3];
        kd4.x = k_[0] * (1.f + (ic_[0] - 1.f) * ka[0]); kd4.y = k_[1] * (1.f + (ic_[1] - 1.f) * ka[1]);
        kd4.z = k_[2] * (1.f + (ic_[2] - 1.f) * ka[2]); kd4.w = k_[3] * (1.f + (ic_[3] - 1.f) * ka[3]);
        *(float4*)(dst) = make_float4(kk_[0], kk_[1], kk_[2], kk_[3]);
        *(float4*)(dst + 64) = w4;
        *(float4*)(dst + 128) = b4;
        *(float4*)(dst + 192) = kd4;
        *(float4*)(dst + 256) = make_float4(r_[0], r_[1], r_[2], r_[3]);
        { const int t6 = tid & 63; float* dv = buf + (nb * SCH + (t6 >> 2)) * SROW + 320 + (t6 & 3) * 4; *(float4*)dv = make_float4(bflo(g_v.x), bfhi(g_v.x), bflo(g_v.y), bfhi(g_v.y)); }
    };
    __syncthreads();
    gload(sA, 0); swrite(sA, 0);
    gload(sA, 1);
    __syncthreads();
    __builtin_amdgcn_s_setprio(3);
    typedef float f32x2 __attribute__((ext_vector_type(2)));
    f32x2 Sa = {0.f, 0.f}, Sb = {0.f, 0.f};
    const int mycg = lane & 15;
    const bool b3 = (mycg & 8) != 0, b2 = (mycg & 4) != 0, b1 = (mycg & 2) != 0, b0 = (mycg & 1) != 0;
    constexpr int NCH = LK / SCH;
    auto body = [&](int ch, SSet& ld, const SSet& wr) {
        const int cur = ch & 1;
        gload(ld, ch + 2 < NCH ? ch + 2 : NCH - 1);
        const float* bp = buf + cur * SCH * SROW;
        float yp[SCH];
        float4 kk = *(const float4*)(bp + cg4), w = *(const float4*)(bp + 64 + cg4), bb = *(const float4*)(bp + 128 + cg4);
        float4 kd = *(const float4*)(bp + 192 + cg4), r = *(const float4*)(bp + 256 + cg4);
        float vv = bp[320 + lr];
#pragma unroll
        for (int st = 0; st < SCH; st++) {
            const float* qn = bp + (st + 1 < SCH ? st + 1 : st) * SROW;
            const float4 nkk = *(const float4*)(qn + cg4), nw = *(const float4*)(qn + 64 + cg4), nbb = *(const float4*)(qn + 128 + cg4);
            const float4 nkd = *(const float4*)(qn + 192 + cg4), nr = *(const float4*)(qn + 256 + cg4);
            const float nvv = qn[320 + lr];
            const f32x2 vv2 = {vv, vv};
            const f32x2 pr = Sa * f32x2{kk.x, kk.y} + Sb * f32x2{kk.z, kk.w};
            const f32x2 aa = Sa * f32x2{w.x, w.y} + vv2 * f32x2{kd.x, kd.y};
            const f32x2 ab = Sb * f32x2{w.z, w.w} + vv2 * f32x2{kd.z, kd.w};
            const float sk = rowsum16(pr.x + pr.y);
            const f32x2 sk2 = {sk, sk};
            Sa = aa - sk2 * f32x2{bb.x, bb.y};
            Sb = ab - sk2 * f32x2{bb.z, bb.w};
            const f32x2 py = Sa * f32x2{r.x, r.y} + Sb * f32x2{r.z, r.w};
            yp[st] = py.x + py.y;
            kk = nkk; w = nw; bb = nbb; kd = nkd; r = nr; vv = nvv;
        }
        float t8[8], t4[4], t2[2];
#pragma unroll
        for (int j = 0; j < 8; j++) { const float keep = b3 ? yp[8 + j] : yp[j], send = b3 ? yp[j] : yp[8 + j]; t8[j] = keep + dppf<0x128>(send); }
#pragma unroll
        for (int j = 0; j < 4; j++) { const float keep = b2 ? t8[4 + j] : t8[j], send = b2 ? t8[j] : t8[4 + j]; t4[j] = keep + dppf<0x141>(send); }
#pragma unroll
        for (int j = 0; j < 2; j++) { const float keep = b1 ? t4[2 + j] : t4[j], send = b1 ? t4[j] : t4[2 + j]; t2[j] = keep + dppf<0x4E>(send); }
        const float ykeep = (b0 ? t2[1] : t2[0]) + dppf<0xB1>(b0 ? t2[0] : t2[1]);
        ybuf[cur * SCH * 16 + mycg * 16 + lr] = ykeep;
        swrite(wr, cur ^ 1);
        __syncthreads();
        if (ch * SCH >= CTXL || need_ctx_out) {
            const int row = row_of(ch * SCH + st_s);
            Y[(size_t)d * NROW * 512 + (size_t)row * 512 + h * 64 + i0 + (tid & 15)] = f2bf(ybuf[cur * SCH * 16 + st_s * 16 + (tid & 15)]);
        }
    };
#pragma unroll 1
    for (int ch = 0; ch < NCH; ch += 2) { body(ch, sB, sA); body(ch + 1, sA, sB); }
    __builtin_amdgcn_s_setprio(0);
}

constexpr int ATT_SMEM = 2 * 64 * 64 * 2 + 2 * 64 * 64 * 2;

__device__ __forceinline__ void attn_item(const P& p, int b, int kvh, int qpos0, int key_begin, int key_end, float cexp, float mexp, char* smem) {
    const bf16_t* Ks = (const bf16_t*)smem;
    const bf16_t* Vs = Ks + 2 * 64 * 64;
    const bf16_t* Q = (const bf16_t*)(p.ws + OFF_Q);
    bf16_t* O = (bf16_t*)(p.ws + OFF_AO);
    const bf16_t* kbase = (const bf16_t*)(p.ws + OFF_K) + (size_t)((b * 2 + kvh) * LK) * 64;
    const bf16_t* vbase = (const bf16_t*)(p.ws + OFF_VT) + (size_t)((b * 2 + kvh) * 64) * LK;
    const int tid = otid(), lane = tid & 63, wid = tid >> 6, head = kvh * 4 + wid, l31 = lane & 31, hh = lane >> 5;
    const size_t rowoff = ((size_t)((b * 8 + head) * LK + qpos0 + l31)) * 64;
    const float nm = __builtin_bit_cast(float, __builtin_amdgcn_readfirstlane(__builtin_bit_cast(int, -mexp)));
    bf16x8 qa[4], qb[4];
#pragma unroll
    for (int s = 0; s < 4; s++) { qa[s] = *(const bf16x8*)(Q + rowoff + 16 * s + hh * 8); qb[s] = *(const bf16x8*)(Q + rowoff + 32 * 64 + 16 * s + hh * 8); }
    f32x16 oa0, oa1, ob0, ob1;
#pragma unroll
    for (int i = 0; i < 16; i++) { oa0[i] = 0.f; oa1[i] = 0.f; ob0[i] = 0.f; ob1[i] = 0.f; }
    float lsa = 0.f, lsb = 0.f;
    const int wu = __builtin_amdgcn_readfirstlane(wid);
    auto stage = [&](int nb, int key0) {
#pragma unroll
        for (int i = 0; i < 2; i++) {
            const int piece = wu * 2 + i, row = piece * 8 + (lane >> 3), kc = (lane & 7) ^ ((row >> 1) & 7);
            __builtin_amdgcn_global_load_lds((const GAS void*)(kbase + (size_t)(key0 + row) * 64 + kc * 8), (LDSAS void*)(smem + nb * 8192 + piece * 1024), 16, 0, 0);
            __builtin_amdgcn_global_load_lds((const GAS void*)(vbase + (size_t)row * LK + key0 + kc * 8), (LDSAS void*)(smem + 16384 + nb * 8192 + piece * 1024), 16, 0, 0);
        }
    };
    const int fsw = (l31 >> 1) & 7;
    __syncthreads();
    stage(0, key_begin);
    __syncthreads();
    const int nt = (key_end - key_begin) / 64;
    for (int t = 0; t < nt; t++) {
        const int cur = t & 1;
        if (t + 1 < nt) stage(cur ^ 1, key_begin + (t + 1) * 64);
#pragma unroll
        for (int kb = 0; kb < 2; kb++) {
            f32x16 sa, sb;
#pragma unroll
            for (int i = 0; i < 16; i++) { sa[i] = nm; sb[i] = nm; }
#pragma unroll
            for (int s = 0; s < 4; s++) {
                const bf16x8 a = *(const bf16x8*)(Ks + (cur * 64 + kb * 32 + l31) * 64 + (((2 * s + hh) ^ fsw) << 3));
                sa = __builtin_amdgcn_mfma_f32_32x32x16_bf16(a, qa[s], sa, 0, 0, 0);
                sb = __builtin_amdgcn_mfma_f32_32x32x16_bf16(a, qb[s], sb, 0, 0, 0);
            }
#pragma unroll
            for (int i = 0; i < 16; i++) {
                sa[i] = __builtin_amdgcn_exp2f(sa[i]); sb[i] = __builtin_amdgcn_exp2f(sb[i]);
                lsa += sa[i]; lsb += sb[i];
            }
#pragma unroll
            for (int ss = 0; ss < 2; ss++) {
                u32x4 pa, pb;
#pragma unroll
                for (int j = 0; j < 4; j++) {
                    pa[j] = cvtpk(sa[8 * ss + 2 * j], sa[8 * ss + 2 * j + 1]);
                    pb[j] = cvtpk(sb[8 * ss + 2 * j], sb[8 * ss + 2 * j + 1]);
                }
                const bf16x8 pfa = __builtin_bit_cast(bf16x8, pa), pfb = __builtin_bit_cast(bf16x8, pb);
                const int kofs = ((4 * kb + 2 * ss + hh) ^ fsw) << 3;
                {
                    const bf16x8 va = *(const bf16x8*)(Vs + (cur * 64 + l31) * 64 + kofs);
                    oa0 = __builtin_amdgcn_mfma_f32_32x32x16_bf16(va, pfa, oa0, 0, 0, 0);
                    ob0 = __builtin_amdgcn_mfma_f32_32x32x16_bf16(va, pfb, ob0, 0, 0, 0);
                }
                {
                    const bf16x8 va = *(const bf16x8*)(Vs + (cur * 64 + 32 + l31) * 64 + kofs);
                    oa1 = __builtin_amdgcn_mfma_f32_32x32x16_bf16(va, pfa, oa1, 0, 0, 0);
                    ob1 = __builtin_amdgcn_mfma_f32_32x32x16_bf16(va, pfb, ob1, 0, 0, 0);
                }
            }
        }
        __syncthreads();
    }
    lsa += __shfl_xor(lsa, 32); lsb += __shfl_xor(lsb, 32);
    const float ia = 1.f / lsa, ib = 1.f / lsb;
    bf16_t* orow = O + rowoff;
#pragma unroll
    for (int g4 = 0; g4 < 4; g4++) {
        uint2 w0, w1, x0, x1;
        w0.x = cvtpk(oa0[4 * g4] * ia, oa0[4 * g4 + 1] * ia); w0.y = cvtpk(oa0[4 * g4 + 2] * ia, oa0[4 * g4 + 3] * ia);
        w1.x = cvtpk(oa1[4 * g4] * ia, oa1[4 * g4 + 1] * ia); w1.y = cvtpk(oa1[4 * g4 + 2] * ia, oa1[4 * g4 + 3] * ia);
        x0.x = cvtpk(ob0[4 * g4] * ib, ob0[4 * g4 + 1] * ib); x0.y = cvtpk(ob0[4 * g4 + 2] * ib, ob0[4 * g4 + 3] * ib);
        x1.x = cvtpk(ob1[4 * g4] * ib, ob1[4 * g4 + 1] * ib); x1.y = cvtpk(ob1[4 * g4 + 2] * ib, ob1[4 * g4 + 3] * ib);
        *(uint2*)(orow + 8 * g4 + 4 * hh) = w0;
        *(uint2*)(orow + 32 + 8 * g4 + 4 * hh) = w1;
        *(uint2*)(orow + 32 * 64 + 8 * g4 + 4 * hh) = x0;
        *(uint2*)(orow + 32 * 64 + 32 + 8 * g4 + 4 * hh) = x1;
    }
}

__device__ __forceinline__ void convert_row_fp6(const float4 q0, const float4 q1, const float4 q2, const float4 q3, unsigned char* __restrict__ dst, float* __restrict__ sc, int row, int lane) {
    const float4 v[4] = {q0, q1, q2, q3}; float am = 0.f;
#pragma unroll
    for (int j = 0; j < 4; j++) am = fmaxf(am, fmaxf(fmaxf(fabsf(v[j].x), fabsf(v[j].y)), fmaxf(fabsf(v[j].z), fabsf(v[j].w))));
    am = wave_max(am);
    const float q = (am > 0.f) ? 7.5f / am : 1.f;
    unsigned c[16];
#pragma unroll
    for (int j = 0; j < 4; j++) {
        const float e4[4] = {v[j].x * q, v[j].y * q, v[j].z * q, v[j].w * q};
#pragma unroll
        for (int k = 0; k < 4; k++) {
            const unsigned bits = __float_as_uint(e4[k]);
            const float a = fabsf(e4[k]);
            int e = (int)((bits >> 23) & 255u) - 127; e = e < 0 ? 0 : (e > 2 ? 2 : e);
            const float inv_step = __uint_as_float((unsigned)(130 - e) << 23);
            int code = (int)rintf(a * inv_step) + 8 * e; code = code > 31 ? 31 : code;
            c[4 * j + k] = (unsigned)code | ((bits >> 31) << 5);
        }
    }
    unsigned o[3];
    o[0] = c[0] | (c[1] << 6) | (c[2] << 12) | (c[3] << 18) | (c[4] << 24) | (c[5] << 30);
    o[1] = (c[5] >> 2) | (c[6] << 4) | (c[7] << 10) | (c[8] << 16) | (c[9] << 22) | (c[10] << 28);
    o[2] = (c[10] >> 4) | (c[11] << 2) | (c[12] << 8) | (c[13] << 14) | (c[14] << 20) | (c[15] << 26);
    U3 st; st.x = o[0]; st.y = o[1]; st.z = o[2];
    *(U3*)(dst + (size_t)row * EROW + lane * 12) = st;
    if (lane == 0) sc[row] = (am > 0.f) ? am * (1.f / 7.5f) : 1.f;
}
__device__ __forceinline__ void phase_expert_convert(const P& p, int l, int bid, int nblk) {
    const int lane = otid() & 63, gw = bid * 4 + (otid() >> 6), nw = nblk * 4;
    const float* su = p.eu + (size_t)l * NEXP * D; const float* sv = p.ev + (size_t)l * NEXP * D;
    auto srcrow = [&](int r) -> const float4* { return (const float4*)((r < NEXP ? su : sv) + (size_t)(r < NEXP ? r : r - NEXP) * D) + lane * 4; };
    float4 a0 = make_float4(0.f, 0.f, 0.f, 0.f), a1 = a0, a2 = a0, a3 = a0;
    if (gw < 2 * NEXP) { const float4* sp = srcrow(gw); a0 = sp[0]; a1 = sp[1]; a2 = sp[2]; a3 = sp[3]; }
    for (int r = gw; r < 2 * NEXP; r += nw) {
        const float4* sp = srcrow(r + nw < 2 * NEXP ? r + nw : r);
        const float4 n0 = sp[0], n1 = sp[1], n2 = sp[2], n3 = sp[3];
        if (r < NEXP) convert_row_fp6(a0, a1, a2, a3, (unsigned char*)(p.ws + OFF_EUB), (float*)(p.ws + OFF_USC), r, lane);
        else convert_row_fp6(a0, a1, a2, a3, (unsigned char*)(p.ws + OFF_EVB), (float*)(p.ws + OFF_VSC), r - NEXP, lane);
        a0 = n0; a1 = n1; a2 = n2; a3 = n3;
    }
}

__device__ __forceinline__ void phase_rwkv_out(const P& p, int l, int nrows, int bid, int nblk) {
    const bf16_t* Y = (const bf16_t*)(p.ws + OFF_Y);
    const bf16_t* E = (const bf16_t*)(p.ws + OFF_E);
    const bf16_t* GATE = (const bf16_t*)(p.ws + OFF_GATE);
    const float* BON = (const float*)(p.ws + OFF_BON);
    bf16_t* RWO = (bf16_t*)(p.ws + OFF_RWO);
    const int lane = otid() & 63, gw = bid * 4 + (otid() >> 6), nw = nblk * 4;
    const int c0 = lane * 8;
    float lw[8], lb[8];
#pragma unroll
    for (int j = 0; j < 8; j++) { lw[j] = p.ln_w[l * 512 + c0 + j]; lb[j] = p.ln_b[l * 512 + c0 + j]; }
    auto ldrow = [&](int r, uint4& a, uint4& b, uint4& c, uint4& d, float& e) {
        const size_t q = (size_t)r * 512 + c0;
        a = *(const uint4*)(Y + q); b = *(const uint4*)(Y + (size_t)NROW * 512 + q); c = *(const uint4*)(E + 2 * (SZ_E1 / 2) + q); d = *(const uint4*)(GATE + q);
        e = BON[(size_t)r * 8 + (lane >> 3)];
    };
    uint4 y0 = make_uint4(0, 0, 0, 0), y1 = y0, vv = y0, gg = y0; float bon = 0.f;
    if (gw < nrows) ldrow(gw, y0, y1, vv, gg, bon);
    for (int row = gw; row < nrows; row += nw) {
        const size_t o = (size_t)row * 512 + c0;
        uint4 ny0, ny1, nvv, ngg; float nbon;
        ldrow(row + nw < nrows ? row + nw : row, ny0, ny1, nvv, ngg, nbon);
        float y[8] = {bflo(y0.x) + bflo(y1.x), bfhi(y0.x) + bfhi(y1.x), bflo(y0.y) + bflo(y1.y), bfhi(y0.y) + bfhi(y1.y),
                      bflo(y0.z) + bflo(y1.z), bfhi(y0.z) + bfhi(y1.z), bflo(y0.w) + bflo(y1.w), bfhi(y0.w) + bfhi(y1.w)};
        const float v[8] = {bflo(vv.x), bfhi(vv.x), bflo(vv.y), bfhi(vv.y), bflo(vv.z), bfhi(vv.z), bflo(vv.w), bfhi(vv.w)};
        const float g[8] = {bflo(gg.x), bfhi(gg.x), bflo(gg.y), bfhi(gg.y), bflo(gg.z), bfhi(gg.z), bflo(gg.w), bfhi(gg.w)};
        float s = 0.f;
#pragma unroll
        for (int j = 0; j < 8; j++) s += y[j];
        s += __shfl_xor(s, 1); s += __shfl_xor(s, 2); s += __shfl_xor(s, 4);
        const float mu = s * (1.f / 64.f);
        float q = 0.f;
#pragma unroll
        for (int j = 0; j < 8; j++) { y[j] -= mu; q += y[j] * y[j]; }
        q += __shfl_xor(q, 1); q += __shfl_xor(q, 2); q += __shfl_xor(q, 4);
        const float rs = rsqrtf(q * (1.f / 64.f) + 64e-5f);
        float outv[8];
#pragma unroll
        for (int j = 0; j < 8; j++) outv[j] = (y[j] * rs * lw[j] + lb[j] + bon * v[j]) * g[j];
        store8bf(RWO + o, outv);
        y0 = ny0; y1 = ny1; vv = nvv; gg = ngg; bon = nbon;
    }
}

__device__ __forceinline__ void phase_outproj(const P& p, int l, int nrows, const float* xlat, const float* xctx, char* smem, int bid, int nblk) {
    AMix ap{(const bf16_t*)(p.ws + OFF_AO), (const bf16_t*)(p.ws + OFF_RWO)};
    EpiOutProj epi{xlat, xctx, (bf16_t*)(p.ws + OFF_XB), (float*)(p.ws + OFF_CTXS), (const float*)(p.ws + OFF_MOD) + (size_t)l * 5 * 6144 + 2 * 1024};
    const bf16_t* Bt = (const bf16_t*)(p.ws + OFF_WOUT) + (size_t)l * D * D;
    const int MT = nrows / 128;
    for (int it = xcd_vbid(bid, nblk); it < MT * 8; it += nblk) gemm_tile(ap, Bt, D, D, (it >> 3) * 128, (it & 7) * 128, smem, epi);
}

__device__ __forceinline__ void phase_scores(const P& p, int l, int nrows, char* smem, int bid, int nblk) {
    ARow ap{(const bf16_t*)(p.ws + OFF_H), D};
    EpiTopk epi{(float*)(p.ws + OFF_TOPV), (int*)(p.ws + OFF_TOPI)};
    const bf16_t* Bt = (const bf16_t*)(p.ws + OFF_WST) + (size_t)l * 2048 * D;
    const int MT = nrows / 128;
    for (int it = xcd_vbid(bid, nblk); it < MT * 16; it += nblk) {
        const int g = it >> 7, r = it & 127, nt = r >> 3, mt = g * 8 + (r & 7);
        gemm_tile(ap, Bt, D, D, mt * 128, nt * 128, smem, epi);
    }
}

constexpr int PEER_TOK = 16, NSLAB = 16, SLAB_SHIFT = 10, SOFF_LD = 20;
constexpr int PEER_SMEM = PEER_TOK * 128 * 4 * 4 + PEER_TOK * SOFF_LD * 4;

template <int NT>
__device__ __forceinline__ void peer_group(const P& p, int l, int row0, int ntok, char* smem) {
    int* uidx = (int*)smem;
    float* ugate = (float*)(smem + PEER_TOK * 128 * 4);
    int* sidx = (int*)(smem + 2 * PEER_TOK * 128 * 4);
    float* sgate = (float*)(smem + 3 * PEER_TOK * 128 * 4);
    int* soff = (int*)(smem + 4 * PEER_TOK * 128 * 4);
    const float* TV = (const float*)(p.ws + OFF_TOPV);
    const int* TI = (const int*)(p.ws + OFF_TOPI);
    const bf16_t* H = (const bf16_t*)(p.ws + OFF_H);
    const float* mod = (const float*)(p.ws + OFF_MOD) + (size_t)l * 5 * 6144;
    const unsigned char* EU = (const unsigned char*)(p.ws + OFF_EUB);
    const unsigned char* EV = (const unsigned char*)(p.ws + OFF_EVB);
    const float* USC = (const float*)(p.ws + OFF_USC);
    const float* VSC = (const float*)(p.ws + OFF_VSC);
    float* ctxs = (float*)(p.ws + OFF_CTXS);
    const int tid = otid(), lane = tid & 63, wid = tid >> 6;
    const __amdgpu_buffer_rsrc_t rsu = __builtin_amdgcn_make_buffer_rsrc((void*)EU, (short)0, NEXP * EROW, 0x00020000);
    const __amdgpu_buffer_rsrc_t rsv = __builtin_amdgcn_make_buffer_rsrc((void*)EV, (short)0, NEXP * EROW, 0x00020000);
    const unsigned l12 = (unsigned)lane * 12u;
    __syncthreads();
    {
        const int tok = tid >> 3, hd = tid & 7, row = row0 + tok;
        if (tok < ntok) {
            const float* pv1 = TV + ((size_t)row * 16 + hd * 2) * 16; const float* pv2 = pv1 + 16;
            const int* pi1 = TI + ((size_t)row * 16 + hd * 2) * 16; const int* pi2 = pi1 + 16;
            float v1[16], v2[16];
#pragma unroll
            for (int j = 0; j < 4; j++) {
                float4 a = ((const float4*)pv1)[j], c = ((const float4*)pv2)[j];
                v1[4 * j] = a.x; v1[4 * j + 1] = a.y; v1[4 * j + 2] = a.z; v1[4 * j + 3] = a.w;
                v2[4 * j] = c.x; v2[4 * j + 1] = c.y; v2[4 * j + 2] = c.z; v2[4 * j + 3] = c.w;
            }
            unsigned top[16];
#pragma unroll
            for (int j = 0; j < 16; j++) top[j] = 0u;
#pragma unroll
            for (int a = 0; a < 16; a++)
#pragma unroll
                for (int c = 0; c < 16; c++)
                    if ((a + 1) * (c + 1) <= 16) ins16(top, (ford(v1[a] + v2[c]) & 0xFFFFFF00u) | (unsigned)(255 - (a * 16 + c)));
            float sc[16]; float sum = 0.f;
            const float m = funord(top[0] & 0xFFFFFF00u);
#pragma unroll
            for (int j = 0; j < 16; j++) { sc[j] = __expf(funord(top[j] & 0xFFFFFF00u) - m); sum += sc[j]; }
            const float inv = 1.f / sum;
#pragma unroll
            for (int j = 0; j < 16; j++) {
                const int code = 255 - (int)(top[j] & 255u);
                uidx[tok * 128 + hd * 16 + j] = pi1[code >> 4] * 128 + pi2[code & 15];
                ugate[tok * 128 + hd * 16 + j] = sc[j] * inv;
            }
        }
    }
    __syncthreads();
#pragma unroll 1
    for (int tk = 0; tk < NT; tk++) {
        const int tok = tk * 4 + wid;
        if (tok < ntok) {
            const int i0 = uidx[tok * 128 + lane], i1 = uidx[tok * 128 + 64 + lane];
            const float g0 = ugate[tok * 128 + lane], g1 = ugate[tok * 128 + 64 + lane];
            const int s0 = i0 >> SLAB_SHIFT, s1 = i1 >> SLAB_SHIFT;
            int base = 0, pos0 = 0, pos1 = 0;
            for (int s = 0; s < NSLAB; s++) {
                const unsigned long long m0 = __ballot(s0 == s), m1 = __ballot(s1 == s);
                const int r0 = __builtin_amdgcn_mbcnt_hi((unsigned)(m0 >> 32), __builtin_amdgcn_mbcnt_lo((unsigned)m0, 0u));
                const int r1 = __builtin_amdgcn_mbcnt_hi((unsigned)(m1 >> 32), __builtin_amdgcn_mbcnt_lo((unsigned)m1, 0u));
                const int c0 = __popcll(m0);
                if (s0 == s) pos0 = base + r0;
                if (s1 == s) pos1 = base + c0 + r1;
                if (lane == 0) soff[tok * SOFF_LD + s] = base;
                base += c0 + __popcll(m1);
            }
            if (lane == 0) soff[tok * SOFF_LD + NSLAB] = base;
            sidx[tok * 128 + pos0] = i0; sidx[tok * 128 + pos1] = i1;
            sgate[tok * 128 + pos0] = g0; sgate[tok * 128 + pos1] = g1;
        }
    }
    __syncthreads();
    float* sdot = ugate;
    {
        bf2_t hp[NT][8];
#pragma unroll
        for (int tk = 0; tk < NT; tk++) {
            const int row = row0 + tk * 4 + wid;
            const uint4 h0 = ((const uint4*)(H + (size_t)row * D))[2 * lane], h1 = ((const uint4*)(H + (size_t)row * D))[2 * lane + 1];
            hp[tk][0] = __builtin_bit_cast(bf2_t, h0.x); hp[tk][1] = __builtin_bit_cast(bf2_t, h0.y); hp[tk][2] = __builtin_bit_cast(bf2_t, h0.z); hp[tk][3] = __builtin_bit_cast(bf2_t, h0.w);
            hp[tk][4] = __builtin_bit_cast(bf2_t, h1.x); hp[tk][5] = __builtin_bit_cast(bf2_t, h1.y); hp[tk][6] = __builtin_bit_cast(bf2_t, h1.z); hp[tk][7] = __builtin_bit_cast(bf2_t, h1.w);
        }
        U3 ua[8], ub[8];
        auto issue = [&](U3 (&dst)[8], int tk, int r) {
            const int* ip = sidx + (tk * 4 + wid) * 128 + 8 * r;
#pragma unroll
            for (int q = 0; q < 8; q++) { const u32x3 t = __builtin_amdgcn_raw_buffer_load_b96(rsu, __umul24((unsigned)ip[q], (unsigned)EROW) + l12, 0, 0); dst[q].x = t.x; dst[q].y = t.y; dst[q].z = t.z; }
        };
        auto reduce = [&](const U3 (&src)[8], int tk, int r) {
            float a[8];
#pragma unroll
            for (int q = 0; q < 8; q += 2) {
                u32x6 pk; pk[0] = src[q].x; pk[1] = src[q].y; pk[2] = src[q].z; pk[3] = src[q + 1].x; pk[4] = src[q + 1].y; pk[5] = src[q + 1].z;
                const bf16x32 g = __builtin_amdgcn_cvt_scalef32_pk32_bf16_fp6(pk, 1.0f);
                float a0 = 0.f, a1 = 0.f;
#pragma unroll
                for (int d = 0; d < 8; d++) {
                    bf2_t x0, x1; x0[0] = g[2 * d]; x0[1] = g[2 * d + 1]; x1[0] = g[16 + 2 * d]; x1[1] = g[17 + 2 * d];
                    a0 = __builtin_amdgcn_fdot2_f32_bf16(x0, hp[tk][d], a0, false);
                    a1 = __builtin_amdgcn_fdot2_f32_bf16(x1, hp[tk][d], a1, false);
                }
                a[q] = a0; a[q + 1] = a1;
            }
            const bool b0 = lane & 1, b1 = lane & 2, b2 = lane & 4;
            float t4[4], t2[2];
#pragma unroll
            for (int j = 0; j < 4; j++) { const float keep = b2 ? a[4 + j] : a[j], send = b2 ? a[j] : a[4 + j]; t4[j] = keep + dppf<0x141>(send); }
#pragma unroll
            for (int j = 0; j < 2; j++) { const float keep = b1 ? t4[2 + j] : t4[j], send = b1 ? t4[j] : t4[2 + j]; t2[j] = keep + dppf<0x4E>(send); }
            float v = (b0 ? t2[1] : t2[0]) + dppf<0xB1>(b0 ? t2[0] : t2[1]);
            v += dppf<0x128>(v);
            v += __builtin_bit_cast(float, __builtin_amdgcn_ds_swizzle(__builtin_bit_cast(int, v), 0x401F));
            v += __shfl_xor(v, 32);
            if (lane < 8) sdot[(tk * 4 + wid) * 128 + 8 * r + lane] = v;
        };
        if (NT > 1) {
            issue(ua, 0, 0);
#pragma unroll 1
            for (int r = 0; r < 16; r++) {
#pragma unroll
                for (int tk = 0; tk < NT; tk++) {
                    const int ntk = (tk + 1) & (NT - 1), nr = (tk == NT - 1) ? ((r < 15) ? r + 1 : r) : r;
                    if ((tk & 1) == 0) { issue(ub, ntk, nr); reduce(ua, tk, r); }
                    else { issue(ua, ntk, nr); reduce(ub, tk, r); }
                }
            }
        } else {
#pragma unroll 1
            for (int r = 0; r < 16; r++) { issue(ua, 0, r); reduce(ua, 0, r); }
        }
    }
    __syncthreads();
    for (int i = tid; i < PEER_TOK * 128; i += NTHR) {
        if ((i >> 7) < ntok) { const int ex = sidx[i]; const float d = sdot[i] * USC[ex]; sdot[i] = sgate[i] * 0.5f * d * (1.f + erff(d * 0.70710678118654752f)) * VSC[ex]; }
    }
    __syncthreads();
    {
        float acc[NT][16];
#pragma unroll
        for (int tk = 0; tk < NT; tk++)
#pragma unroll
            for (int j = 0; j < 16; j++) acc[tk][j] = 0.f;
        U3 ua[8], ub[8];
        auto issue = [&](U3 (&dst)[8], int tk, int r) {
            const int* ip = sidx + (tk * 4 + wid) * 128 + 8 * r;
#pragma unroll
            for (int q = 0; q < 8; q++) { const u32x3 t = __builtin_amdgcn_raw_buffer_load_b96(rsv, __umul24((unsigned)ip[q], (unsigned)EROW) + l12, 0, 0); dst[q].x = t.x; dst[q].y = t.y; dst[q].z = t.z; }
        };
        auto accum = [&](const U3 (&src)[8], float (&ac)[16], int tk, int r) {
            const float* cp = sdot + (tk * 4 + wid) * 128 + 8 * r;
#pragma unroll
            for (int q = 0; q < 8; q += 2) {
                u32x6 pk; pk[0] = src[q].x; pk[1] = src[q].y; pk[2] = src[q].z; pk[3] = src[q + 1].x; pk[4] = src[q + 1].y; pk[5] = src[q + 1].z;
                const f32x32 f = __builtin_amdgcn_cvt_scalef32_pk32_f32_fp6(pk, 1.0f);
                const float c0 = cp[q], c1 = cp[q + 1];
#pragma unroll
                for (int j = 0; j < 16; j++) ac[j] += c0 * f[j];
#pragma unroll
                for (int j = 0; j < 16; j++) ac[j] += c1 * f[16 + j];
            }
        };
        if (NT > 1) {
            issue(ua, 0, 0);
#pragma unroll 1
            for (int r = 0; r < 16; r++) {
#pragma unroll
                for (int tk = 0; tk < NT; tk++) {
                    const int ntk = (tk + 1) & (NT - 1), nr = (tk == NT - 1) ? ((r < 15) ? r + 1 : r) : r;
                    if ((tk & 1) == 0) { issue(ub, ntk, nr); accum(ua, acc[tk], tk, r); }
                    else { issue(ua, ntk, nr); accum(ub, acc[tk], tk, r); }
                }
            }
        } else {
#pragma unroll 1
            for (int r = 0; r < 16; r++) { issue(ua, 0, r); accum(ua, acc[0], 0, r); }
        }
#pragma unroll
        for (int tk = 0; tk < NT; tk++) {
            const int tok = tk * 4 + wid;
            if (tok < ntok) {
                const int row = row0 + tok;
                int b, pos; bool isctx; rowinfo(row, b, pos, isctx);
                const int sm = isctx ? 4 : b;
                float* xr = (isctx ? ctxs + (size_t)(row - NLAT) * D : p.out + (size_t)row * D) + lane * 16;
                const float* gf = mod + sm * 6144 + 5 * 1024 + lane * 16;
                float xin[16];
                if (isctx) {
#pragma unroll
                    for (int j = 0; j < 4; j++) { const float4 t4 = ((const float4*)xr)[j]; xin[4 * j] = t4.x; xin[4 * j + 1] = t4.y; xin[4 * j + 2] = t4.z; xin[4 * j + 3] = t4.w; }
                } else {
                    const uint4* xb = (const uint4*)((const bf16_t*)(p.ws + OFF_XB) + (size_t)row * D + lane * 16);
                    unpack8(xb[0], xin); unpack8(xb[1], xin + 8);
                }
                float xs[16]; float ss = 0.f;
#pragma unroll
                for (int j = 0; j < 4; j++) {
                    float4 x = make_float4(xin[4 * j], xin[4 * j + 1], xin[4 * j + 2], xin[4 * j + 3]); const float4 g = ((const float4*)gf)[j];
                    x.x += g.x * acc[tk][4 * j]; x.y += g.y * acc[tk][4 * j + 1]; x.z += g.z * acc[tk][4 * j + 2]; x.w += g.w * acc[tk][4 * j + 3];
                    ((float4*)xr)[j] = x;
                    xs[4 * j] = x.x; xs[4 * j + 1] = x.y; xs[4 * j + 2] = x.z; xs[4 * j + 3] = x.w;
                    ss += x.x * x.x + x.y * x.y + x.z * x.z + x.w * x.w;
                }
                if (l == 0) {
                    const float rinv = rsqrtf(wave_sum_dpp(ss) * (1.f / D) + 1e-6f);
                    const float* gn = p.norm_mix + D + lane * 16;
                    const float* sh = mod + 5 * 6144 + sm * 6144 + lane * 16; const float* sc = sh + 1024;
                    float hv[16];
#pragma unroll
                    for (int j = 0; j < 16; j++) hv[j] = xs[j] * rinv * gn[j] * (1.f + sc[j]) + sh[j];
                    bf16_t* hr = (bf16_t*)(p.ws + OFF_H) + (size_t)row * D + lane * 16;
                    store8bf(hr, hv); store8bf(hr + 8, hv + 8);
                }
            }
        }
    }
}

__device__ __forceinline__ void phase_peer(const P& p, int l, int nrows, char* smem, int bid, int nblk) {
    for (int g = bid; g < NLAT / PEER_TOK; g += nblk) peer_group<4>(p, l, g * PEER_TOK, PEER_TOK, smem);
    if (nrows > NLAT) {
        const int per = 4;
        for (int g = bid; g < NCTX / per; g += nblk) peer_group<1>(p, l, NLAT + g * per, per, smem);
    }
}

#define XB_TMO      128
#define XB_XCNT(j)  (256  + 64 * (j))
#define XB_XSUB(j)  (1280 + 64 * (j))
#define XB_XGEN(j)  (2304 + 64 * (j))
#define XB_TOP      3328
#define XB_TOPGEN   3392
#define XCD_BAR_WORDS 3456
#define XB_SPIN_CAP (1u << 22)
#define LAS __attribute__((address_space(3)))
__device__ __forceinline__ unsigned xb_ld(unsigned* p) { return __hip_atomic_load(p, __ATOMIC_RELAXED, __HIP_MEMORY_SCOPE_AGENT); }
__device__ __forceinline__ unsigned xb_add(unsigned* p, unsigned v) { return __hip_atomic_fetch_add(p, v, __ATOMIC_RELAXED, __HIP_MEMORY_SCOPE_AGENT); }
__device__ __forceinline__ unsigned xb_xcc_id() { return (unsigned)__builtin_amdgcn_s_getreg((3 << 11) | 20) & 0xFu; }
#define XB_SPIN(cond, bar) do { unsigned _sp = 0; while (cond) { __builtin_amdgcn_s_sleep(1); \
    if ((++_sp & 255u) == 0u) { if (xb_ld(&(bar)[XB_TMO])) break; if (_sp > XB_SPIN_CAP) { atomicAdd(&(bar)[XB_TMO], 1u); break; } } } } while (0)
struct XcdBarrier { unsigned* bar; unsigned x; volatile LAS unsigned* st; };
__device__ __forceinline__ XcdBarrier xcd_barrier_post(unsigned* bar, volatile LAS unsigned* st) {
    XcdBarrier b; b.bar = bar; b.x = xb_xcc_id(); b.st = st;
    if (threadIdx.x == 0) (void)xb_add(&bar[XB_XCNT(b.x)], 1u);
    return b;
}
__device__ __forceinline__ void xcd_barrier_complete(unsigned* bar, unsigned x, unsigned& nloc, unsigned& nx) {
    const unsigned G = gridDim.x * gridDim.y * gridDim.z;
    unsigned sum, cnt, mine, sp = 0u;
    for (;;) {
        sum = 0u; cnt = 0u; mine = 0u;
#pragma unroll
        for (unsigned j = 0; j < 16; ++j) { const unsigned c = xb_ld(&bar[XB_XCNT(j)]); sum += c; cnt += (c > 0u) ? 1u : 0u; mine = (j == x) ? c : mine; }
        if (sum == G) break;
        __builtin_amdgcn_s_sleep(1);
        if ((++sp & 255u) == 0u) { if (xb_ld(&bar[XB_TMO])) break; if (sp > XB_SPIN_CAP) { atomicAdd(&bar[XB_TMO], 1u); break; } }
    }
    nloc = mine > 0u ? mine : 1u; nx = cnt > 0u ? cnt : 1u;
}
__device__ __forceinline__ void xcd_barrier(const XcdBarrier& b) {
    asm volatile("s_waitcnt vmcnt(0)" ::: "memory");
    __syncthreads();
    if (threadIdx.x == 0) {
        unsigned* bar = b.bar;
        __builtin_amdgcn_s_waitcnt(0);
        unsigned nloc = b.st[0], nx = b.st[1];
        if (nloc == 0u) { xcd_barrier_complete(bar, b.x, nloc, nx); b.st[0] = nloc; b.st[1] = nx; }
        const unsigned old = xb_add(&bar[XB_XSUB(b.x)], 1u);
        const unsigned gen = old / nloc;
        if (old + 1u == (gen + 1u) * nloc) {
            __builtin_amdgcn_fence(__ATOMIC_RELEASE, "agent");
            asm volatile("s_waitcnt vmcnt(0)" ::: "memory");
            const unsigned og = xb_add(&bar[XB_TOP], 1u);
            const unsigned tg = og / nx;
            if (og + 1u == (tg + 1u) * nx) xb_add(&bar[XB_TOPGEN], 1u);
            else XB_SPIN(xb_ld(&bar[XB_TOPGEN]) == tg, bar);
            __builtin_amdgcn_fence(__ATOMIC_ACQUIRE, "agent");
            xb_add(&bar[XB_XGEN(b.x)], 1u);
            asm volatile("s_waitcnt vmcnt(0)" ::: "memory");
        } else {
            XB_SPIN(xb_ld(&bar[XB_XGEN(b.x)]) == gen, bar);
            __builtin_amdgcn_fence(__ATOMIC_ACQUIRE, "agent");
            asm volatile("s_waitcnt vmcnt(0)" ::: "memory");
        }
    }
    __syncthreads();
}

extern __shared__ __attribute__((aligned(16))) char dyn_smem[];

constexpr size_t OFF_CTR = WS_END;
constexpr size_t OFF_BAR = WS_END + 256;
constexpr size_t CTL_BYTES = OFF_LORAW - WS_END;
static_assert(OFF_LORAW >= WS_END + 256 + XCD_BAR_WORDS * 4, "control words overlap the LoRA weight copies");
constexpr size_t WS_END2 = OFF_LORAW + 2 * LORAW_L * 2;
constexpr int MEGA_SMEM = GEMM_SMEM + 16;

__device__ __forceinline__ void phase_scan_attn(const P& p, int l, bool need_ctx, char* smem, int bid, int nblk, unsigned* ctr) {
    if (nblk >= 256 && bid < 256) scan_item(p, l, (bid & 7) * 32 + (bid >> 3), need_ctx, smem);
    else if (nblk < 256) { for (int it = bid; it < 256; it += nblk) scan_item(p, l, it, need_ctx, smem); }
    const int lane = otid() & 63;
    const float gq = wave_max(fabsf(p.q_gain[l * 64 + lane])), gk = wave_max(fabsf(p.k_gain[l * 64 + lane]));
    const float cexp = 0.125f * 1.4426950408889634f;
    const float mexp = 8.f * gq * gk * 1.4426950408889634f;
    const int nlat = NB * 2 * (SEQ / 64), nctx = need_ctx ? NB * 2 * (CTXL / 64) : 0;
    int* slot = (int*)(smem + ATT_SMEM);
    for (;;) {
        __syncthreads();
        if (otid() == 0) *slot = (int)atomicAdd(ctr, 1u);
        __syncthreads();
        const int it = *slot;
        if (it >= nlat + nctx) break;
        if (it < nlat) {
            const int bk = it / (SEQ / 64), qt = it % (SEQ / 64);
            attn_item(p, bk >> 1, bk & 1, qt * 64, 0, LK, cexp, mexp, smem);
        } else {
            const int j = it - nlat, bk = j / (CTXL / 64), qt = j % (CTXL / 64);
            attn_item(p, bk >> 1, bk & 1, SEQ + qt * 64, SEQ, LK, cexp, mexp, smem);
        }
    }
}

typedef __attribute__((address_space(4))) const P* KP;
__device__ __forceinline__ P load_params() {
    KP q = (KP)__builtin_amdgcn_kernarg_segment_ptr();
    asm volatile("" : "+s"(q));
    P r;
    r.x = q->x; r.c = q->c; r.ctx = q->ctx; r.c_ctx = q->c_ctx; r.mod_w = q->mod_w; r.mod_b = q->mod_b; r.norm_mix = q->norm_mix; r.norm_ffn = q->norm_ffn;
    r.w_in = q->w_in; r.q_gain = q->q_gain; r.k_gain = q->k_gain; r.shift_taps = q->shift_taps; r.decay_base = q->decay_base; r.decay_up = q->decay_up;
    r.iclr_base = q->iclr_base; r.iclr_up = q->iclr_up; r.gate_up = q->gate_up; r.k_k = q->k_k; r.k_a = q->k_a; r.r_k = q->r_k; r.ln_w = q->ln_w; r.ln_b = q->ln_b;
    r.w_out = q->w_out; r.peer_query = q->peer_query; r.sk1 = q->sk1; r.sk2 = q->sk2; r.eu = q->eu; r.ev = q->ev; r.out = q->out; r.ws = q->ws;
    return r;
}
#define LP load_params()

__global__ void __launch_bounds__(NTHR, 2) k_mega(P p_unused) {
    cg::grid_group grid = cg::this_grid();
    char* smem = dyn_smem;
    const int bid = blockIdx.x, nblk = gridDim.x;
    char* const ws0 = LP.ws;
    volatile LAS unsigned* xst = (volatile LAS unsigned*)&dyn_smem[GEMM_SMEM];
    if (threadIdx.x == 0) { xst[0] = 0u; xst[1] = 0u; }
    __syncthreads();
    XcdBarrier xb = xcd_barrier_post((unsigned*)(ws0 + OFF_BAR), xst);
    xb.bar = nullptr;
    phase_prep(LP, smem, bid, nblk);
    grid.sync();
    phase_prep2(LP, bid, nblk);
    phase_ws(LP, smem, bid, nblk);
    { XcdBarrier xq = xb; xq.bar = (unsigned*)(LP.ws + OFF_BAR); { unsigned xx = xb.x; asm volatile("" : "+s"(xx)); xq.x = xx; } xcd_barrier(xq); }

    for (int l = 0; l < 2; l++) {
        const bool need_ctx = (l == 0);
        const int nrows2 = need_ctx ? NROW : NLAT;
        if (l == 0) {
            const P p = LP;
            phase_normmod<false>(p.x, p.ctx, p.norm_mix, (const float*)(p.ws + OFF_MOD), 0, 1, (bf16_t*)(p.ws + OFF_H), NROW, bid, nblk);
            { XcdBarrier xq = xb; xq.bar = (unsigned*)(LP.ws + OFF_BAR); { unsigned xx = xb.x; asm volatile("" : "+s"(xx)); xq.x = xx; } xcd_barrier(xq); }
        }
        phase_inproj(LP, l, smem, bid, nblk);
        { XcdBarrier xq = xb; xq.bar = (unsigned*)(LP.ws + OFF_BAR); { unsigned xx = xb.x; asm volatile("" : "+s"(xx)); xq.x = xx; } xcd_barrier(xq); }
        phase_features(LP, l, smem, bid, nblk, (unsigned*)(LP.ws + OFF_CTR) + 2 + l);
        { XcdBarrier xq = xb; xq.bar = (unsigned*)(LP.ws + OFF_BAR); { unsigned xx = xb.x; asm volatile("" : "+s"(xx)); xq.x = xx; } xcd_barrier(xq); }
        phase_scan_attn(LP, l, need_ctx, smem, bid, nblk, (unsigned*)(LP.ws + OFF_CTR) + l);
        { XcdBarrier xq = xb; xq.bar = (unsigned*)(LP.ws + OFF_BAR); { unsigned xx = xb.x; asm volatile("" : "+s"(xx)); xq.x = xx; } xcd_barrier(xq); }
        phase_rwkv_out(LP, l, nrows2, bid, nblk);
        phase_expert_convert(LP, l, bid, nblk);
        { XcdBarrier xq = xb; xq.bar = (unsigned*)(LP.ws + OFF_BAR); { unsigned xx = xb.x; asm volatile("" : "+s"(xx)); xq.x = xx; } xcd_barrier(xq); }
        {
            const P p = LP;
            const float* xlat = (l == 0) ? p.x : p.out;
            const float* xctx = (l == 0) ? p.ctx : (const float*)(p.ws + OFF_CTXS);
            phase_outproj(p, l, nrows2, xlat, xctx, smem, bid, nblk);
        }
        { XcdBarrier xq = xb; xq.bar = (unsigned*)(LP.ws + OFF_BAR); { unsigned xx = xb.x; asm volatile("" : "+s"(xx)); xq.x = xx; } xcd_barrier(xq); }
        {
            const P p = LP;
            phase_normmod<true>((const float*)(p.ws + OFF_XB), (const float*)(p.ws + OFF_CTXS), p.norm_ffn + l * D, (const float*)(p.ws + OFF_MOD) + (size_t)l * 5 * 6144, 3, 4, (bf16_t*)(p.ws + OFF_H), nrows2, bid, nblk);
        }
        { XcdBarrier xq = xb; xq.bar = (unsigned*)(LP.ws + OFF_BAR); { unsigned xx = xb.x; asm volatile("" : "+s"(xx)); xq.x = xx; } xcd_barrier(xq); }
        phase_scores(LP, l, nrows2, smem, bid, nblk);
        { XcdBarrier xq = xb; xq.bar = (unsigned*)(LP.ws + OFF_BAR); { unsigned xx = xb.x; asm volatile("" : "+s"(xx)); xq.x = xx; } xcd_barrier(xq); }
        phase_peer(LP, l, nrows2, smem, bid, nblk);
        if (l == 0) { XcdBarrier xq = xb; xq.bar = (unsigned*)(LP.ws + OFF_BAR); { unsigned xx = xb.x; asm volatile("" : "+s"(xx)); xq.x = xx; } xcd_barrier(xq); }
    }
}

}

extern "C" void kernel_launch(void* const* d_in, const int* in_sizes, int n_in, void* d_out, int out_size, void* d_ws, size_t ws_size,
                              hipStream_t stream) {
    static int grid_blocks = 0;
    if (grid_blocks == 0) {
        if (n_in != 28 || ws_size < WS_END2) { fprintf(stderr, "kernel_launch: unexpected n_in %d or ws_size %zu (need %zu)\n", n_in, ws_size, (size_t)WS_END2); grid_blocks = -1; return; }
        int dev = 0, cus = 0, per_cu = 0;
        hipGetDevice(&dev);
        hipDeviceGetAttribute(&cus, hipDeviceAttributeMultiprocessorCount, dev);
        hipFuncSetAttribute((const void*)k_mega, hipFuncAttributeMaxDynamicSharedMemorySize, MEGA_SMEM);
        hipOccupancyMaxActiveBlocksPerMultiprocessor(&per_cu, (const void*)k_mega, NTHR, MEGA_SMEM);
        if (per_cu < 1) { fprintf(stderr, "kernel_launch: occupancy query returned %d\n", per_cu); grid_blocks = -1; return; }
        if (per_cu > 2) per_cu = 2;
        grid_blocks = cus * per_cu;
    }
    if (grid_blocks < 0) return;
    P p{};
    const float** f = (const float**)&p;
    for (int i = 0; i < 28; i++) f[i] = (const float*)d_in[i];
    p.out = (float*)d_out;
    p.ws = (char*)d_ws;
    hipMemsetAsync((char*)d_ws + OFF_CTR, 0, CTL_BYTES, stream);
    void* args[] = {&p};
    hipError_t e = hipLaunchCooperativeKernel((const void*)k_mega, dim3(grid_blocks), dim3(NTHR), args, MEGA_SMEM, stream);
    if (e != hipSuccess) fprintf(stderr, "cooperative launch failed: %s (grid %d)\n", hipGetErrorString(e), grid_blocks);
}
static_assert(WS_END2 <= 536870912ull, "workspace too large");
```

```cpp
#include <hip/hip_runtime.h>
#include <hip/hip_cooperative_groups.h>
#include <stdint.h>
#include <stdio.h>

namespace cg = cooperative_groups;

typedef unsigned short bf16_t;
typedef short bf16x8 __attribute__((ext_vector_type(8)));
typedef float f32x4 __attribute__((ext_vector_type(4)));
typedef float f32x16 __attribute__((ext_vector_type(16)));
typedef unsigned u32x4 __attribute__((ext_vector_type(4)));
typedef __bf16 bf2_t __attribute__((ext_vector_type(2)));
typedef float f32x2_t __attribute__((ext_vector_type(2)));
typedef unsigned u32x6 __attribute__((ext_vector_type(6)));
typedef unsigned u32x16 __attribute__((ext_vector_type(16)));
typedef float f32x32 __attribute__((ext_vector_type(32)));
typedef __bf16 bf16x32 __attribute__((ext_vector_type(32)));
typedef unsigned u32x3 __attribute__((ext_vector_type(3)));
struct __attribute__((packed, aligned(4))) U3 { unsigned x, y, z; };

namespace {
constexpr int D = 1024, NB = 4, SEQ = 8192, CTXL = 256;
constexpr int NLAT = NB * SEQ, NCTX = NB * CTXL, NROW = NLAT + NCTX;
constexpr int LK = SEQ + CTXL;
constexpr int INC = 2688, RWC = 1920;
constexpr int NEXP = 16384;
constexpr int EROW = D * 6 / 8;
constexpr int NTHR = 256;

constexpr size_t al256(size_t x) { return (x + 255) & ~size_t(255); }
constexpr size_t SZ_E1 = size_t(NROW) * 512 * 2;
constexpr size_t OFF_WIN = 0;
constexpr size_t OFF_WOUT = OFF_WIN + al256(size_t(2) * INC * D * 2);
constexpr size_t OFF_WQB = OFF_WOUT + al256(size_t(2) * D * D * 2);
constexpr size_t OFF_SKB = OFF_WQB + al256(size_t(2) * D * 2048 * 2);
constexpr size_t OFF_WST = OFF_SKB + al256(size_t(2) * 2 * 128 * 128 * 2);
constexpr size_t OFF_MODP = OFF_WST + al256(size_t(2) * 2048 * D * 2);
constexpr size_t OFF_MOD = OFF_MODP + al256(size_t(2) * 8 * 5 * 6144 * 4);
constexpr size_t OFF_ROPE = OFF_MOD + al256(size_t(2) * 5 * 6144 * 4);
constexpr size_t OFF_CTXS = OFF_ROPE + al256(size_t(6144) * 4);
constexpr size_t OFF_BON = OFF_CTXS + al256(size_t(NCTX) * D * 4);
constexpr size_t OFF_Q = OFF_BON + al256(size_t(NROW) * 8 * 4);
constexpr size_t OFF_K = OFF_Q + al256(size_t(NB) * 8 * LK * 64 * 2);
constexpr size_t OFF_VT = OFF_K + al256(size_t(NB) * 2 * LK * 64 * 2);
constexpr size_t OFF_PR = OFF_VT + al256(size_t(NB) * 2 * LK * 64 * 2);
constexpr size_t OFF_E = OFF_PR + al256(size_t(NROW) * RWC * 2);
constexpr size_t OFF_GATE = OFF_E + al256(8 * SZ_E1);
constexpr size_t WS_END = OFF_GATE + al256(SZ_E1);
constexpr size_t OFF_LORAW = al256(WS_END + 256 + 3456 * 4);
constexpr size_t LORAW_L = 4 * 512 * 64 + 512 * 128;
constexpr size_t OFF_H = OFF_E;
constexpr size_t OFF_TOPV = OFF_E + 3 * SZ_E1;
constexpr size_t OFF_TOPI = OFF_E + 4 * SZ_E1;
constexpr size_t OFF_RWO = OFF_E + 7 * SZ_E1;
constexpr size_t OFF_Y = OFF_PR;
constexpr size_t OFF_XB = OFF_PR;
constexpr size_t OFF_AO = OFF_PR + al256(2 * SZ_E1);
static_assert(OFF_AO + size_t(NB) * 8 * LK * 64 * 2 <= OFF_E, "attention output overlaps E");
constexpr size_t OFF_EUB = OFF_E + 5 * SZ_E1;
constexpr size_t OFF_EVB = OFF_EUB + size_t(NEXP) * D;
constexpr size_t OFF_USC = OFF_EVB + size_t(NEXP) * D;
constexpr size_t OFF_VSC = OFF_USC + size_t(NEXP) * 4;
static_assert(OFF_VSC + size_t(NEXP) * 4 <= OFF_E + 7 * SZ_E1, "expert tables overlap RWO");

struct P {
    const float *x, *c, *ctx, *c_ctx, *mod_w, *mod_b, *norm_mix, *norm_ffn, *w_in, *q_gain, *k_gain, *shift_taps, *decay_base,
        *decay_up, *iclr_base, *iclr_up, *gate_up, *k_k, *k_a, *r_k, *ln_w, *ln_b, *w_out, *peer_query, *sk1, *sk2, *eu, *ev;
    float* out;
    char* ws;
};

__device__ __forceinline__ int otid() { int t = threadIdx.x; asm volatile("" : "+v"(t)); return t; }
__device__ __forceinline__ bf16_t f2bf(float f) {
    unsigned u = __float_as_uint(f);
    u += 0x7fffu + ((u >> 16) & 1u);
    return (bf16_t)(u >> 16);
}
__device__ __forceinline__ float bf2f(bf16_t h) { return __uint_as_float(((unsigned)h) << 16); }
__device__ __forceinline__ unsigned cvtpk(float lo, float hi) {
    typedef __bf16 bf2v __attribute__((ext_vector_type(2)));
    const bf2v r = {(__bf16)lo, (__bf16)hi};
    return __builtin_bit_cast(unsigned, r);
}
__device__ __forceinline__ float bflo(unsigned u) { return __uint_as_float(u << 16); }
__device__ __forceinline__ float bfhi(unsigned u) { return __uint_as_float(u & 0xffff0000u); }
__device__ __forceinline__ unsigned umed3(unsigned a, unsigned b, unsigned c) {
    unsigned r;
    asm("v_med3_u32 %0,%1,%2,%3" : "=v"(r) : "v"(a), "v"(b), "v"(c));
    return r;
}
template <int CTRL>
__device__ __forceinline__ float dppf(float v) {
    return __builtin_bit_cast(float, __builtin_amdgcn_update_dpp(0, __builtin_bit_cast(int, v), CTRL, 0xF, 0xF, true));
}
template <int CTRL>
__device__ __forceinline__ unsigned dppu(unsigned v) {
    return (unsigned)__builtin_amdgcn_update_dpp(0, (int)v, CTRL, 0xF, 0xF, true);
}
__device__ __forceinline__ float rowsum16(float p) {
    p += dppf<0xB1>(p);
    p += dppf<0x4E>(p);
    p += dppf<0x141>(p);
    p += dppf<0x140>(p);
    return p;
}
__device__ __forceinline__ float wave_sum(float v) {
#pragma unroll
    for (int o = 1; o < 64; o <<= 1) v += __shfl_xor(v, o);
    return v;
}
template <int CTRL, int RM>
__device__ __forceinline__ float dppf_rm(float v) {
    return __builtin_bit_cast(float, __builtin_amdgcn_update_dpp(0, __builtin_bit_cast(int, v), CTRL, RM, 0xF, false));
}
__device__ __forceinline__ float wave_sum_dpp(float p) {
    p = rowsum16(p);
    p += dppf_rm<0x142, 0xA>(p);
    p += dppf_rm<0x143, 0xC>(p);
    return __builtin_bit_cast(float, __builtin_amdgcn_readlane(__builtin_bit_cast(int, p), 63));
}
__device__ __forceinline__ float wave_max(float v) {
#pragma unroll
    for (int o = 1; o < 64; o <<= 1) v = fmaxf(v, __shfl_xor(v, o));
    return v;
}
__device__ __forceinline__ float sigmoidf_(float x) { return __builtin_amdgcn_rcpf(1.f + __expf(-x)); }

__device__ __forceinline__ void rowinfo(int row, int& b, int& pos, bool& isctx) {
    if (row < NLAT) { b = row >> 13; pos = row & (SEQ - 1); isctx = false; }
    else { int r = row - NLAT; b = r >> 8; pos = SEQ + (r & (CTXL - 1)); isctx = true; }
}
__device__ __forceinline__ unsigned ford(float f) { unsigned u = __float_as_uint(f); return (u & 0x80000000u) ? ~u : (u | 0x80000000u); }
__device__ __forceinline__ float funord(unsigned o) { unsigned u = (o & 0x80000000u) ? (o & 0x7fffffffu) : ~o; return __uint_as_float(u); }
__device__ __forceinline__ void ins16(unsigned (&tv)[16], unsigned key) {
#pragma unroll
    for (int j = 15; j >= 1; --j) tv[j] = umed3(tv[j - 1], tv[j], key);
    tv[0] = tv[0] > key ? tv[0] : key;
}

__device__ __forceinline__ void transpose_item(const float* __restrict__ src, int K, int N, bf16_t* __restrict__ dst, int item, float* tile) {
    const int nblk = N / 64, kb = item / nblk, nb = item % nblk, k0 = kb * 64, n0 = nb * 64, t = otid();
#pragma unroll 4
    for (int i = 0; i < 16; i++) { int kk = i * 4 + (t >> 6), nn = t & 63; tile[kk * 65 + nn] = src[(size_t)(k0 + kk) * N + n0 + nn]; }
    __syncthreads();
#pragma unroll 4
    for (int i = 0; i < 16; i++) { int nn = i * 4 + (t >> 6), kk = t & 63; dst[(size_t)(n0 + nn) * K + k0 + kk] = f2bf(tile[kk * 65 + nn]); }
    __syncthreads();
}

__device__ __forceinline__ void phase_prep(const P& p, char* smem, int bid, int nblk) {
    float* tile = (float*)smem;
    bf16_t* win = (bf16_t*)(p.ws + OFF_WIN);
    bf16_t* wout = (bf16_t*)(p.ws + OFF_WOUT);
    constexpr int I_IN = (D / 64) * (INC / 64), I_OUT = (D / 64) * (D / 64);
    bf16_t* loraw = (bf16_t*)(p.ws + OFF_LORAW);
    for (int it = bid; it < 2 * I_IN + 2 * I_OUT + 2 * 48; it += nblk) {
        int r = it;
        if (r < 2 * I_IN) { int l = r / I_IN; transpose_item(p.w_in + (size_t)l * D * INC, D, INC, win + (size_t)l * INC * D, r % I_IN, tile); continue; }
        r -= 2 * I_IN;
        if (r < 2 * I_OUT) { int l = r / I_OUT; transpose_item(p.w_out + (size_t)l * D * D, D, D, wout + (size_t)l * D * D, r % I_OUT, tile); continue; }
        r -= 2 * I_OUT;
        {
            const int l = r / 48, q = r % 48;
            bf16_t* dl = loraw + (size_t)l * LORAW_L;
            if (q < 16) transpose_item(p.decay_up + (size_t)(l * 2 + (q >> 3)) * 64 * 512, 64, 512, dl + (size_t)(q >> 3) * 32768, q & 7, tile);
            else if (q < 32) transpose_item(p.iclr_up + (size_t)(l * 2 + ((q - 16) >> 3)) * 64 * 512, 64, 512, dl + (size_t)(2 + ((q - 16) >> 3)) * 32768, q & 7, tile);
            else transpose_item(p.gate_up + (size_t)l * 128 * 512, 128, 512, dl + (size_t)4 * 32768, q - 32, tile);
        }
    }
    bf16_t* wqb = (bf16_t*)(p.ws + OFF_WQB);
    bf16_t* skb = (bf16_t*)(p.ws + OFF_SKB);
    const size_t gt = (size_t)bid * NTHR + otid(), gn = (size_t)nblk * NTHR;
    for (size_t i = gt; i < (size_t)2 * D * 2048 / 4; i += gn) {
        float4 v = ((const float4*)p.peer_query)[i];
        uint2 o; o.x = cvtpk(v.x, v.y); o.y = cvtpk(v.z, v.w);
        ((uint2*)wqb)[i] = o;
    }
    for (size_t i = gt; i < (size_t)2 * 2 * 128 * 128; i += gn) {
        int l = (int)(i / (2 * 16384)), half = (int)((i / 16384) & 1), e = (int)(i & 16383);
        const float* s = half ? p.sk2 : p.sk1;
        skb[i] = f2bf(s[(size_t)l * 16384 + e]);
    }
    float* rope = (float*)(p.ws + OFF_ROPE);
    for (size_t i = gt; i < 3072; i += gn) {
        int f = (int)(i & 15), pos = (int)(i >> 4);
        float inv = exp2f(-(float)f * (2.0f / 32.0f) * 13.287712379549449f);
        float pp = (pos < 128) ? (float)pos : (float)(pos - 128);
        float ang = pp * inv;
        float cs = cosf(ang), sn = sinf(ang);
        if (pos < 128) { rope[pos * 16 + f] = cs; rope[2048 + pos * 16 + f] = sn; }
        else { rope[4096 + (pos - 128) * 16 + f] = cs; rope[5120 + (pos - 128) * 16 + f] = sn; }
    }
    float* modp = (float*)(p.ws + OFF_MODP);
    float* sl = (float*)smem;
    for (int it = bid; it < 2 * 8 * 24; it += nblk) {
        int l = it / (8 * 24), kc = (it / 24) & 7, nb = it % 24;
        __syncthreads();
        for (int i = otid(); i < 5 * 128; i += NTHR) {
            int s = i >> 7, k = kc * 128 + (i & 127);
            float cv = (s < 4) ? p.c[s * D + k] : p.c_ctx[k];
            sl[i] = cv / (1.f + __expf(-cv));
        }
        __syncthreads();
        int n = nb * 256 + otid();
        float a0 = 0, a1 = 0, a2 = 0, a3 = 0, a4 = 0;
        const float* w = p.mod_w + ((size_t)l * D + kc * 128) * 6144 + n;
#pragma unroll 8
        for (int k = 0; k < 128; k++) {
            float wv = w[(size_t)k * 6144];
            a0 += sl[k] * wv; a1 += sl[128 + k] * wv; a2 += sl[256 + k] * wv; a3 += sl[384 + k] * wv; a4 += sl[512 + k] * wv;
        }
        float* o = modp + ((size_t)(l * 8 + kc) * 5) * 6144 + n;
        o[0] = a0; o[6144] = a1; o[2 * 6144] = a2; o[3 * 6144] = a3; o[4 * 6144] = a4;
    }
}

__device__ __forceinline__ void phase_prep2(const P& p, int bid, int nblk) {
    const float* modp = (const float*)(p.ws + OFF_MODP);
    float* mod = (float*)(p.ws + OFF_MOD);
    for (int i = bid * NTHR + otid(); i < 2 * 5 * 6144; i += nblk * NTHR) {
        int l = i / (5 * 6144), r = i % (5 * 6144), n = r % 6144;
        float a = p.mod_b[l * 6144 + n];
#pragma unroll
        for (int kc = 0; kc < 8; kc++) a += modp[(size_t)(l * 8 + kc) * 5 * 6144 + r];
        mod[i] = a;
    }
}

template <bool LATBF>
__device__ __forceinline__ void phase_normmod(const float* xlat, const float* xctx, const float* gain, const float* mod, int shi, int sci, bf16_t* H,
                              int nrows, int bid, int nblk) {
    const int lane = otid() & 63, gw = bid * 4 + (otid() >> 6), nw = nblk * 4;
    for (int row = gw; row < nrows; row += nw) {
        int b, pos; bool isctx; rowinfo(row, b, pos, isctx);
        const int s = isctx ? 4 : b;
        const float* src = isctx ? xctx + (size_t)(row - NLAT) * D : xlat + (size_t)row * D;
        float4 v[4]; float ss = 0.f;
        if (LATBF && !isctx) {
            const uint2* sb = (const uint2*)((const bf16_t*)xlat + (size_t)row * D);
#pragma unroll
            for (int j = 0; j < 4; j++) { const uint2 u = sb[j * 64 + lane]; v[j] = make_float4(bflo(u.x), bfhi(u.x), bflo(u.y), bfhi(u.y)); }
        } else {
#pragma unroll
            for (int j = 0; j < 4; j++) v[j] = ((const float4*)src)[j * 64 + lane];
        }
#pragma unroll
        for (int j = 0; j < 4; j++) ss += v[j].x * v[j].x + v[j].y * v[j].y + v[j].z * v[j].z + v[j].w * v[j].w;
        ss = wave_sum(ss);
        const float rinv = rsqrtf(ss * (1.f / D) + 1e-6f);
        const float* sh = mod + s * 6144 + shi * 1024; const float* sc = mod + s * 6144 + sci * 1024;
#pragma unroll
        for (int j = 0; j < 4; j++) {
            int idx = j * 64 + lane;
            float4 g = ((const float4*)gain)[idx], a = ((const float4*)sc)[idx], c = ((const float4*)sh)[idx];
            float h0 = v[j].x * rinv * g.x * (1.f + a.x) + c.x, h1 = v[j].y * rinv * g.y * (1.f + a.y) + c.y;
            float h2 = v[j].z * rinv * g.z * (1.f + a.z) + c.z, h3 = v[j].w * rinv * g.w * (1.f + a.w) + c.w;
            uint2 o; o.x = cvtpk(h0, h1); o.y = cvtpk(h2, h3);
            ((uint2*)(H + (size_t)row * D))[idx] = o;
        }
    }
}

constexpr int LDT = 72;
constexpr int CSLD = 132;
constexpr int GEMM_SMEM = 2 * 2 * 128 * LDT * 2;

struct ARow { const bf16_t* A; int lda; __device__ __forceinline__ const bf16_t* operator()(int row, int k) const { return A + (size_t)row * lda + k; } };
struct AMix {
    const bf16_t* Q; const bf16_t* R;
    __device__ __forceinline__ const bf16_t* operator()(int row, int k) const {
        if (k < 512) { int b, pos; bool c; rowinfo(row, b, pos, c); return Q + ((size_t)((b * 8 + (k >> 6)) * LK + pos)) * 64 + (k & 63); }
        return R + (size_t)row * 512 + (k - 512);
    }
};

#define GAS __attribute__((address_space(1)))
#define LDSAS __attribute__((address_space(3)))
template <class AP, class EPI>
__device__ __forceinline__ void gemm_tile(const AP& ap, const bf16_t* __restrict__ Bt, int ldb, int K, int m0, int n0, char* smem, const EPI& epi) {
    const bf16_t* As = (const bf16_t*)smem;
    const bf16_t* Bs = As + 2 * 128 * 64;
    const int tid = otid(), lane = tid & 63, wid = tid >> 6, wr = wid >> 1, wc = wid & 1;
    const int wu = __builtin_amdgcn_readfirstlane(wid);
    f32x4 acc[4][4];
#pragma unroll
    for (int i = 0; i < 4; i++)
#pragma unroll
        for (int j = 0; j < 4; j++) acc[i][j] = f32x4{0.f, 0.f, 0.f, 0.f};
    auto stage = [&](int buf, int k0) {
#pragma unroll
        for (int i = 0; i < 4; i++) {
            const int piece = wu * 4 + i, row = piece * 8 + (lane >> 3), kc = (lane & 7) ^ ((row >> 1) & 7);
            __builtin_amdgcn_global_load_lds((const GAS void*)ap(m0 + row, k0 + kc * 8), (LDSAS void*)(smem + buf * 16384 + piece * 1024), 16, 0, 0);
            __builtin_amdgcn_global_load_lds((const GAS void*)(Bt + (size_t)(n0 + row) * ldb + k0 + kc * 8), (LDSAS void*)(smem + 32768 + buf * 16384 + piece * 1024), 16, 0, 0);
        }
    };
    stage(0, 0);
    __syncthreads();
    const int nk = K / 64;
    for (int kt = 0; kt < nk; kt++) {
        const int cur = kt & 1;
        if (kt + 1 < nk) stage(cur ^ 1, (kt + 1) * 64);
#pragma unroll
        for (int ks = 0; ks < 2; ks++) {
            const int kch = ks * 4 + (lane >> 4);
            bf16x8 af[4], bfr[4];
#pragma unroll
            for (int mi = 0; mi < 4; mi++) { const int row = wr * 64 + mi * 16 + (lane & 15); af[mi] = *(const bf16x8*)(As + cur * 8192 + row * 64 + ((kch ^ ((row >> 1) & 7)) << 3)); }
#pragma unroll
            for (int ni = 0; ni < 4; ni++) { const int row = wc * 64 + ni * 16 + (lane & 15); bfr[ni] = *(const bf16x8*)(Bs + cur * 8192 + row * 64 + ((kch ^ ((row >> 1) & 7)) << 3)); }
#pragma unroll
            for (int mi = 0; mi < 4; mi++)
#pragma unroll
                for (int ni = 0; ni < 4; ni++) acc[mi][ni] = __builtin_amdgcn_mfma_f32_16x16x32_bf16(af[mi], bfr[ni], acc[mi][ni], 0, 0, 0);
        }
        __syncthreads();
    }
    float* Cs = (float*)smem;
#pragma unroll
    for (int mi = 0; mi < 4; mi++)
#pragma unroll
        for (int ni = 0; ni < 4; ni++)
#pragma unroll
            for (int j = 0; j < 4; j++) Cs[(wr * 64 + mi * 16 + (lane >> 4) * 4 + j) * CSLD + wc * 64 + ni * 16 + (lane & 15)] = acc[mi][ni][j];
    __syncthreads();
    epi(Cs, m0, n0);
    __syncthreads();
}

__device__ __forceinline__ void store8bf(bf16_t* dst, const float* v) {
    uint4 o; o.x = cvtpk(v[0], v[1]); o.y = cvtpk(v[2], v[3]); o.z = cvtpk(v[4], v[5]); o.w = cvtpk(v[6], v[7]);
    *(uint4*)dst = o;
}

struct EpiInProj {
    bf16_t *Q, *K, *VT, *PR; const float *qg, *kg, *rope;
    __device__ __forceinline__ void operator()(const float* Cs, int m0, int n0) const {
        const int t = otid(), nt = n0 >> 7;
        int b, pos0; bool isctx; rowinfo(m0, b, pos0, isctx);
        if (nt <= 4) {
            const int r = t & 127, hh = t >> 7;
            const float* src = Cs + r * CSLD + hh * 64;
            float v[64]; float ss = 0.f;
#pragma unroll
            for (int i = 0; i < 16; i++) { float4 f = *(const float4*)(src + 4 * i); v[4 * i] = f.x; v[4 * i + 1] = f.y; v[4 * i + 2] = f.z; v[4 * i + 3] = f.w; ss += f.x * f.x + f.y * f.y + f.z * f.z + f.w * f.w; }
            const float rinv = rsqrtf(ss * (1.f / 64.f) + 1e-6f);
            const float* g = (nt == 4) ? kg : qg;
            const float qs = (nt == 4) ? 1.f : 0.125f * 1.4426950408889634f;
#pragma unroll
            for (int d = 0; d < 64; d++) v[d] = v[d] * (rinv * qs) * g[d];
            if (!isctx) {
                const int tp = pos0 + r, prow = tp >> 6, pcol = tp & 63;
                const float *cr = rope + prow * 16, *sr = rope + 2048 + prow * 16, *cc = rope + 4096 + pcol * 16, *sc = rope + 5120 + pcol * 16;
#pragma unroll
                for (int f = 0; f < 16; f++) {
                    float c = cr[f], s = sr[f], x1 = v[f], x2 = v[16 + f];
                    v[f] = x1 * c - x2 * s; v[16 + f] = x2 * c + x1 * s;
                    c = cc[f]; s = sc[f]; x1 = v[32 + f]; x2 = v[48 + f];
                    v[32 + f] = x1 * c - x2 * s; v[48 + f] = x2 * c + x1 * s;
                }
            }
            bf16_t* dst = (nt == 4) ? K + ((size_t)((b * 2 + hh) * LK + pos0 + r)) * 64 : Q + ((size_t)((b * 8 + nt * 2 + hh) * LK + pos0 + r)) * 64;
#pragma unroll
            for (int i = 0; i < 8; i++) store8bf(dst + 8 * i, v + 8 * i);
        } else if (nt == 5) {
            const int c = t >> 1, half = t & 1, kvh = c >> 6, d = c & 63;
            bf16_t* dst = VT + ((size_t)((b * 2 + kvh) * 64 + d)) * LK + pos0 + half * 64;
#pragma unroll
            for (int i = 0; i < 8; i++) {
                float v[8];
#pragma unroll
                for (int j = 0; j < 8; j++) v[j] = Cs[(half * 64 + (i >> 1) * 16 + (i & 1) * 4 + (j & 3) + 8 * (j >> 2)) * CSLD + c];
                store8bf(dst + 8 * i, v);
            }
        } else {
            const int r = t >> 1, half = t & 1;
            const float* src = Cs + r * CSLD + half * 64;
            bf16_t* dst = PR + (size_t)(m0 + r) * RWC + (nt - 6) * 128 + half * 64;
#pragma unroll
            for (int i = 0; i < 8; i++) {
                float4 f0 = *(const float4*)(src + 8 * i), f1 = *(const float4*)(src + 8 * i + 4);
                float v[8] = {f0.x, f0.y, f0.z, f0.w, f1.x, f1.y, f1.z, f1.w};
                store8bf(dst + 8 * i, v);
            }
        }
    }
};

struct EpiOutProj {
    const float *xlat, *xctx; bf16_t* olat; float* octx; const float* gm;
    __device__ __forceinline__ void operator()(const float* Cs, int m0, int n0) const {
        const int t = otid();
        int b, pos0; bool isctx; rowinfo(m0, b, pos0, isctx);
        const int s = isctx ? 4 : b;
        const float* g = gm + s * 6144 + n0;
        const float* xin = isctx ? xctx + (size_t)(m0 - NLAT) * D : xlat + (size_t)m0 * D;
        if (isctx) {
            float* xo = octx + (size_t)(m0 - NLAT) * D;
#pragma unroll 4
            for (int i = 0; i < 16; i++) {
                int f4 = t + 256 * i, r = f4 >> 5, c4 = (f4 & 31) * 4;
                float4 a = *(const float4*)(Cs + r * CSLD + c4);
                float4 x = *(const float4*)(xin + (size_t)r * D + n0 + c4);
                float4 gg = *(const float4*)(g + c4);
                float4 o; o.x = x.x + gg.x * a.x; o.y = x.y + gg.y * a.y; o.z = x.z + gg.z * a.z; o.w = x.w + gg.w * a.w;
                *(float4*)(xo + (size_t)r * D + n0 + c4) = o;
            }
        } else {
            bf16_t* xo = olat + (size_t)m0 * D;
#pragma unroll 4
            for (int i = 0; i < 16; i++) {
                int f4 = t + 256 * i, r = f4 >> 5, c4 = (f4 & 31) * 4;
                float4 a = *(const float4*)(Cs + r * CSLD + c4);
                float4 x = *(const float4*)(xin + (size_t)r * D + n0 + c4);
                float4 gg = *(const float4*)(g + c4);
                uint2 o; o.x = cvtpk(x.x + gg.x * a.x, x.y + gg.y * a.y); o.y = cvtpk(x.z + gg.z * a.z, x.w + gg.w * a.w);
                *(uint2*)(xo + (size_t)r * D + n0 + c4) = o;
            }
        }
    }
};

struct EpiStoreBf {
    bf16_t* C; int ldc;
    __device__ __forceinline__ void operator()(const float* Cs, int m0, int n0) const {
        const int t = otid(), r = t >> 1, half = t & 1;
        const float* src = Cs + r * CSLD + half * 64;
        bf16_t* dst = C + (size_t)(m0 + r) * ldc + n0 + half * 64;
#pragma unroll
        for (int i = 0; i < 8; i++) {
            float4 f0 = *(const float4*)(src + 8 * i), f1 = *(const float4*)(src + 8 * i + 4);
            float v[8] = {f0.x, f0.y, f0.z, f0.w, f1.x, f1.y, f1.z, f1.w};
            store8bf(dst + 8 * i, v);
        }
    }
};

struct EpiTopk {
    float* TV; int* TI;
    __device__ __forceinline__ void operator()(const float* Cs, int m0, int n0) const {
        const int t = otid(), r = t >> 1, half = t & 1, slice = n0 >> 7;
        const float* src = Cs + r * CSLD + half * 64;
        unsigned top[16];
#pragma unroll
        for (int j = 0; j < 16; j++) top[j] = 0u;
#pragma unroll
        for (int i = 0; i < 16; i++) {
            float4 f = *(const float4*)(src + 4 * i);
            const unsigned base = 127u - (unsigned)(half * 64 + 4 * i);
            ins16(top, (ford(f.x) & 0xFFFFFF80u) | (base));
            ins16(top, (ford(f.y) & 0xFFFFFF80u) | (base - 1));
            ins16(top, (ford(f.z) & 0xFFFFFF80u) | (base - 2));
            ins16(top, (ford(f.w) & 0xFFFFFF80u) | (base - 3));
        }
        asm volatile("s_nop 1" : "+v"(top[0]), "+v"(top[1]), "+v"(top[2]), "+v"(top[3]), "+v"(top[4]), "+v"(top[5]), "+v"(top[6]), "+v"(top[7]),
                                 "+v"(top[8]), "+v"(top[9]), "+v"(top[10]), "+v"(top[11]), "+v"(top[12]), "+v"(top[13]), "+v"(top[14]), "+v"(top[15]));
        unsigned oth[16];
#pragma unroll
        for (int j = 0; j < 16; j++) oth[j] = dppu<0xB1>(top[j]);
#pragma unroll
        for (int j = 0; j < 16; j++) ins16(top, oth[j]);
        const size_t o = ((size_t)(m0 + r) * 16 + slice) * 16;
        if (half == 0) {
#pragma unroll
            for (int j = 0; j < 4; j++) { float4 f; f.x = funord(top[4 * j] & 0xFFFFFF80u); f.y = funord(top[4 * j + 1] & 0xFFFFFF80u); f.z = funord(top[4 * j + 2] & 0xFFFFFF80u); f.w = funord(top[4 * j + 3] & 0xFFFFFF80u); *(float4*)(TV + o + 4 * j) = f; }
        } else {
#pragma unroll
            for (int j = 0; j < 4; j++) { int4 f; f.x = 127 - (int)(top[4 * j] & 127u); f.y = 127 - (int)(top[4 * j + 1] & 127u); f.z = 127 - (int)(top[4 * j + 2] & 127u); f.w = 127 - (int)(top[4 * j + 3] & 127u); *(int4*)(TI + o + 4 * j) = f; }
        }
    }
};

__device__ __forceinline__ void phase_ws(const P& p, char* smem, int bid, int nblk) {
    const bf16_t* wqb = (const bf16_t*)(p.ws + OFF_WQB);
    const bf16_t* skb = (const bf16_t*)(p.ws + OFF_SKB);
    bf16_t* wst = (bf16_t*)(p.ws + OFF_WST);
    for (int it = bid; it < 2 * 16 * 8; it += nblk) {
        const int l = it >> 7, slice = (it >> 3) & 15, nt = it & 7, half = slice & 1;
        ARow ap{skb + (size_t)(l * 2 + half) * 16384, 128};
        EpiStoreBf epi{wst + (size_t)l * 2048 * D + (size_t)slice * 128 * D, D};
        gemm_tile(ap, wqb + (size_t)l * D * 2048 + slice * 128, 2048, 128, 0, nt * 128, smem, epi);
    }
}

__device__ __forceinline__ int xcd_vbid(int bid, int nblk) { return ((nblk & 7) == 0) ? (bid & 7) * (nblk >> 3) + (bid >> 3) : bid; }
__device__ __forceinline__ void phase_inproj(const P& p, int l, char* smem, int bid, int nblk) {
    ARow ap{(const bf16_t*)(p.ws + OFF_H), D};
    EpiInProj epi{(bf16_t*)(p.ws + OFF_Q), (bf16_t*)(p.ws + OFF_K), (bf16_t*)(p.ws + OFF_VT), (bf16_t*)(p.ws + OFF_PR),
                  p.q_gain + l * 64, p.k_gain + l * 64, (const float*)(p.ws + OFF_ROPE)};
    const bf16_t* Bt = (const bf16_t*)(p.ws + OFF_WIN) + (size_t)l * INC * D;
    constexpr int NT = INC / 128, MT = NROW / 128;
    static_assert(MT % 8 == 0, "");
    for (int it = xcd_vbid(bid, nblk); it < MT * NT; it += nblk) {
        const int g = it / (8 * NT), r = it % (8 * NT), nt = r >> 3, mt = g * 8 + (r & 7);
        gemm_tile(ap, Bt, D, D, mt * 128, nt * 128, smem, epi);
    }
}

__device__ __forceinline__ void unpack8(const uint4 u, float* v) {
    v[0] = bflo(u.x); v[1] = bfhi(u.x); v[2] = bflo(u.y); v[3] = bfhi(u.y); v[4] = bflo(u.z); v[5] = bfhi(u.z); v[6] = bflo(u.w); v[7] = bfhi(u.w);
}
__device__ __forceinline__ float sum8(float p) {
    p += dppf<0xB1>(p); p += dppf<0x4E>(p); p += dppf<0x141>(p);
    return p;
}
__device__ __forceinline__ void phase_features_shift(const P& p, int l, unsigned* ctr) {
    const bf16_t* PR = (const bf16_t*)(p.ws + OFF_PR);
    bf16_t* E = (bf16_t*)(p.ws + OFF_E);
    float* BON = (float*)(p.ws + OFF_BON);
    const float* taps = p.shift_taps + (size_t)l * 3 * RWC;
    const size_t ES = SZ_E1 / 2;
    const int tid = otid(), lane = tid & 63, c0 = lane * 8;
    float tp[3][3][8], kkw[8], rkw[8];
#pragma unroll
    for (int a = 0; a < 3; a++)
#pragma unroll
        for (int t = 0; t < 3; t++)
#pragma unroll
            for (int j = 0; j < 8; j++) tp[a][t][j] = taps[t * RWC + a * 512 + c0 + j];
#pragma unroll
    for (int j = 0; j < 8; j++) { kkw[j] = p.k_k[l * 512 + c0 + j]; rkw[j] = p.r_k[l * 512 + c0 + j]; }
    for (;;) {
        unsigned gq = 0u;
        if (lane == 0) gq = atomicAdd(ctr, 1u);
        const int g = __builtin_amdgcn_readfirstlane((int)gq);
        if (g >= NROW / 8) break;
        const int r0 = g * 8;
        const bool isctx = r0 >= NLAT;
        const int tt0 = isctx ? ((r0 - NLAT) & (CTXL - 1)) : (r0 & (SEQ - 1));
        const int L = isctx ? CTXL : SEQ;
        float pv[3][8], cu[3][8], nx[3][8];
#pragma unroll
        for (int a = 0; a < 3; a++) {
            if (tt0 > 0) unpack8(*(const uint4*)(PR + (size_t)(r0 - 1) * RWC + a * 512 + c0), pv[a]);
            else {
#pragma unroll
                for (int j = 0; j < 8; j++) pv[a][j] = 0.f;
            }
            unpack8(*(const uint4*)(PR + (size_t)r0 * RWC + a * 512 + c0), cu[a]);
        }
#pragma unroll
        for (int tok = 0; tok < 8; tok++) {
            const int row = r0 + tok;
#pragma unroll
            for (int a = 0; a < 3; a++) {
                if (tt0 + tok < L - 1) unpack8(*(const uint4*)(PR + (size_t)(row + 1) * RWC + a * 512 + c0), nx[a]);
                else {
#pragma unroll
                    for (int j = 0; j < 8; j++) nx[a][j] = 0.f;
                }
            }
            float rr[8], kk_[8], vv[8], kraw[8]; float ssq = 0.f, bon = 0.f;
#pragma unroll
            for (int j = 0; j < 8; j++) {
                rr[j] = pv[0][j] * tp[0][0][j] + cu[0][j] * tp[0][1][j] + nx[0][j] * tp[0][2][j];
                kk_[j] = pv[1][j] * tp[1][0][j] + cu[1][j] * tp[1][1][j] + nx[1][j] * tp[1][2][j];
                vv[j] = pv[2][j] * tp[2][0][j] + cu[2][j] * tp[2][1][j] + nx[2][j] * tp[2][2][j];
                kraw[j] = kk_[j] * kkw[j]; ssq += kraw[j] * kraw[j]; bon += rr[j] * kk_[j] * rkw[j];
            }
            ssq = sum8(ssq); bon = sum8(bon);
            const float rn = rsqrtf(ssq + 1e-12f);
#pragma unroll
            for (int j = 0; j < 8; j++) kraw[j] *= rn;
            const size_t o = (size_t)row * 512 + c0;
            store8bf(E + o, rr); store8bf(E + ES + o, kk_); store8bf(E + 2 * ES + o, vv); store8bf(E + 3 * ES + o, kraw);
            if ((lane & 7) == 0) BON[(size_t)row * 8 + (lane >> 3)] = bon;
#pragma unroll
            for (int a = 0; a < 3; a++)
#pragma unroll
                for (int j = 0; j < 8; j++) { pv[a][j] = cu[a][j]; cu[a][j] = nx[a][j]; }
        }
    }
}

template <int K>
__device__ __forceinline__ void lora_item(const P& p, int l, int mt, int type, char* smem) {
    constexpr int KP = K + 8;
    bf16_t* As = (bf16_t*)smem;
    bf16_t* Bs = As + 128 * KP;
    const bf16_t* PR = (const bf16_t*)(p.ws + OFF_PR);
    const float* taps = p.shift_taps + (size_t)l * 3 * RWC;
    const int tid = otid(), lane = tid & 63, wid = tid >> 6, wr = wid >> 1, wc = wid & 1;
    const int m0 = mt * 128;
    const int colbase = 1536 + (type < 4 ? type * 64 : 256);
    __syncthreads();
    {
        const int r = tid >> 1, half = tid & 1, row = m0 + r;
        const bool isctx = row >= NLAT;
        const int tt = isctx ? ((row - NLAT) & (CTXL - 1)) : (row & (SEQ - 1));
        const int L = isctx ? CTXL : SEQ;
        const bool hp = tt > 0, hn = tt < L - 1;
#pragma unroll
        for (int g = 0; g < K / 16; g++) {
            const int cl = half * (K / 2) + g * 8, col = colbase + cl;
            float a[8], b[8], c[8], v[8];
            unpack8(*(const uint4*)(PR + (size_t)row * RWC + col), b);
            if (hp) unpack8(*(const uint4*)(PR + (size_t)(row - 1) * RWC + col), a);
            if (hn) unpack8(*(const uint4*)(PR + (size_t)(row + 1) * RWC + col), c);
#pragma unroll
            for (int j = 0; j < 8; j++) {
                float x = b[j] * taps[RWC + col + j];
                if (hp) x += a[j] * taps[col + j];
                if (hn) x += c[j] * taps[2 * RWC + col + j];
                if (type < 2) x = 1.f - 2.f * __builtin_amdgcn_rcpf(1.f + __expf(2.f * x));
                else if (type == 4) x = sigmoidf_(x);
                v[j] = x;
            }
            store8bf(As + r * KP + cl, v);
        }
    }
    const bf16_t* Bt = (const bf16_t*)(p.ws + OFF_LORAW) + (size_t)l * LORAW_L + (size_t)(type < 4 ? type * 32768 : 4 * 32768);
    bf16_t* dst;
    {
        bf16_t* E = (bf16_t*)(p.ws + OFF_E);
        const size_t ES = SZ_E1 / 2;
        dst = (type < 2) ? E + (4 + type) * ES : (type < 4) ? E + (6 + type - 2) * ES : (bf16_t*)(p.ws + OFF_GATE);
    }
    const float* base = (type < 2) ? p.decay_base + (l * 2 + type) * 512 : (type < 4) ? p.iclr_base + (l * 2 + type - 2) * 512 : nullptr;
    const int bo0 = (tid / (K / 8)) * K + (tid % (K / 8)) * 8, bo1 = ((tid + 256) / (K / 8)) * K + ((tid + 256) % (K / 8)) * 8;
    const int bo2 = ((tid + 512) / (K / 8)) * K + ((tid + 512) % (K / 8)) * 8, bo3 = ((tid + 768) / (K / 8)) * K + ((tid + 768) % (K / 8)) * 8;
    const int bl0 = (tid / (K / 8)) * KP + (tid % (K / 8)) * 8, bl1 = ((tid + 256) / (K / 8)) * KP + ((tid + 256) % (K / 8)) * 8;
    const int bl2 = ((tid + 512) / (K / 8)) * KP + ((tid + 512) % (K / 8)) * 8, bl3 = ((tid + 768) / (K / 8)) * KP + ((tid + 768) % (K / 8)) * 8;
    uint4 bp0 = *(const uint4*)(Bt + bo0), bp1 = *(const uint4*)(Bt + bo1), bp2 = bp0, bp3 = bp0;
    if (K == 128) { bp2 = *(const uint4*)(Bt + bo2); bp3 = *(const uint4*)(Bt + bo3); }
#pragma unroll 1
    for (int nt = 0; nt < 8; nt++) {
        __syncthreads();
        *(uint4*)(Bs + bl0) = bp0; *(uint4*)(Bs + bl1) = bp1;
        if (K == 128) { *(uint4*)(Bs + bl2) = bp2; *(uint4*)(Bs + bl3) = bp3; }
        {
            const bf16_t* bn = Bt + (size_t)(nt < 7 ? nt + 1 : 7) * 64 * K;
            bp0 = *(const uint4*)(bn + bo0); bp1 = *(const uint4*)(bn + bo1);
            if (K == 128) { bp2 = *(const uint4*)(bn + bo2); bp3 = *(const uint4*)(bn + bo3); }
        }
        __syncthreads();
        f32x4 acc[4][2];
#pragma unroll
        for (int i = 0; i < 4; i++)
#pragma unroll
            for (int j = 0; j < 2; j++) acc[i][j] = f32x4{0.f, 0.f, 0.f, 0.f};
#pragma unroll
        for (int ks = 0; ks < K / 32; ks++) {
            bf16x8 af[4], bfr[2];
#pragma unroll
            for (int mi = 0; mi < 4; mi++) af[mi] = *(const bf16x8*)(As + (wr * 64 + mi * 16 + (lane & 15)) * KP + ks * 32 + (lane >> 4) * 8);
#pragma unroll
            for (int ni = 0; ni < 2; ni++) bfr[ni] = *(const bf16x8*)(Bs + (wc * 32 + ni * 16 + (lane & 15)) * KP + ks * 32 + (lane >> 4) * 8);
#pragma unroll
            for (int mi = 0; mi < 4; mi++)
#pragma unroll
                for (int ni = 0; ni < 2; ni++) acc[mi][ni] = __builtin_amdgcn_mfma_f32_16x16x32_bf16(bfr[ni], af[mi], acc[mi][ni], 0, 0, 0);
        }
#pragma unroll
        for (int ni = 0; ni < 2; ni++) {
            const int col = nt * 64 + wc * 32 + ni * 16 + (lane >> 4) * 4;
            float4 bs = make_float4(0.f, 0.f, 0.f, 0.f);
            if (type < 4) bs = *(const float4*)(base + col);
            const float bsv[4] = {bs.x, bs.y, bs.z, bs.w};
#pragma unroll
            for (int mi = 0; mi < 4; mi++) {
                const int row = m0 + wr * 64 + mi * 16 + (lane & 15);
                float v[4];
#pragma unroll
                for (int j = 0; j < 4; j++) {
                    v[j] = acc[mi][ni][j] + bsv[j];
                    if (type < 2) v[j] = (-0.60653065971f * 1.4426950408889634f) * sigmoidf_(v[j]);
                    else if (type < 4) v[j] = sigmoidf_(v[j]);
                }
                uint2 o; o.x = cvtpk(v[0], v[1]); o.y = cvtpk(v[2], v[3]);
                *(uint2*)(dst + (size_t)row * 512 + col) = o;
            }
        }
    }
}

__device__ __forceinline__ void phase_features(const P& p, int l, char* smem, int bid, int nblk, unsigned* ctr) {
    for (int it = bid; it < (NROW / 128) * 5; it += nblk) {
        const int mt = it / 5, type = it % 5;
        if (type == 4) lora_item<128>(p, l, mt, 4, smem);
        else lora_item<64>(p, l, mt, type, smem);
    }
    phase_features_shift(p, l, ctr);
}

constexpr int SCH = 16;
constexpr int SROW = 336;
constexpr int SCAN_SMEM = 2 * SCH * SROW * 4 + 2 * SCH * 16 * 4;

__device__ __forceinline__ void scan_item(const P& p, int l, int item, bool need_ctx_out, char* smem) {
    float* buf = (float*)smem;
    float* ybuf = buf + 2 * SCH * SROW;
    const bf16_t* E = (const bf16_t*)(p.ws + OFF_E);
    bf16_t* Y = (bf16_t*)(p.ws + OFF_Y);
    const int sc = item >> 2, rb = item & 3, b = sc >> 4, h = (sc >> 1) & 7, d = sc & 1, i0 = rb * 16;
    const int tid = otid(), lane = tid & 63, wid = tid >> 6, cg4 = (lane & 15) * 4, lr = wid * 4 + (lane >> 4);
    const int st_s = tid >> 4, c4_s = (tid & 15) * 4;
    const size_t ES = SZ_E1 / 2;
    float ka[4];
#pragma unroll
    for (int q = 0; q < 4; q++) ka[q] = p.k_a[l * 512 + h * 64 + c4_s + q];
    const float oma[4] = {1.f - ka[0], 1.f - ka[1], 1.f - ka[2], 1.f - ka[3]};
    auto row_of = [&](int tau) -> int {
        if (tau < CTXL) { int t = d ? (CTXL - 1 - tau) : tau; return NLAT + b * CTXL + t; }
        int t = tau - CTXL; t = d ? (SEQ - 1 - t) : t; return b * SEQ + t;
    };
    struct SSet { uint2 r, k, kk, lw, ic, v; };
    SSet sA, sB;
    const char* Eb = (const char*)E;
    const int sdir = d ? -1 : 1;
    const int rbC = NLAT + b * CTXL + (d ? CTXL - 1 : 0), rbL = b * SEQ + (d ? SEQ - 1 : 0) - sdir * CTXL;
    auto chunk_row0 = [&](int ch) -> int { return (ch * SCH < CTXL ? rbC : rbL) + sdir * (ch * SCH); };
    auto gload = [&](SSet& g, int ch) {
        uint2 &g_r = g.r, &g_k = g.k, &g_kk = g.kk, &g_lw = g.lw, &g_ic = g.ic, &g_v = g.v;
        const int rbase = chunk_row0(ch);
        const unsigned voff = (unsigned)(rbase + sdir * st_s) * 1024u + (unsigned)(h * 64 + c4_s) * 2u;
        g_r = *(const uint2*)(Eb + voff); g_k = *(const uint2*)(Eb + ES * 2 + voff); g_kk = *(const uint2*)(Eb + 3 * ES * 2 + voff);
        g_lw = *(const uint2*)(Eb + (size_t)(4 + d) * ES * 2 + voff); g_ic = *(const uint2*)(Eb + (size_t)(6 + d) * ES * 2 + voff);
        { const int t6 = tid & 63; const unsigned voff2 = (unsigned)(rbase + sdir * (t6 >> 2)) * 1024u + (unsigned)(h * 64 + i0 + (t6 & 3) * 4) * 2u; g_v = *(const uint2*)(Eb + 2 * ES * 2 + voff2); }
    };
    auto swrite = [&](const SSet& g, int nb) {
        const uint2 g_r = g.r, g_k = g.k, g_kk = g.kk, g_lw = g.lw, g_ic = g.ic, g_v = g.v;
        float* dst = buf + (nb * SCH + st_s) * SROW + c4_s;
        float r_[4] = {bflo(g_r.x), bfhi(g_r.x), bflo(g_r.y), bfhi(g_r.y)};
        float k_[4] = {bflo(g_k.x), bfhi(g_k.x), bflo(g_k.y), bfhi(g_k.y)};
        float kk_[4] = {bflo(g_kk.x), bfhi(g_kk.x), bflo(g_kk.y), bfhi(g_kk.y)};
        float lw_[4] = {bflo(g_lw.x), bfhi(g_lw.x), bflo(g_lw.y), bfhi(g_lw.y)};
        float ic_[4] = {bflo(g_ic.x), bfhi(g_ic.x), bflo(g_ic.y), bfhi(g_ic.y)};
        float4 w4, b4, kd4;
        w4.x = __builtin_amdgcn_exp2f(lw_[0]); w4.y = __builtin_amdgcn_exp2f(lw_[1]); w4.z = __builtin_amdgcn_exp2f(lw_[2]); w4.w = __builtin_amdgcn_exp2f(lw_[3]);
        {
            const f32x2_t kk0 = {kk_[0], kk_[1]}, kk1 = {kk_[2], kk_[3]}, ic0 = {ic_[0], ic_[1]}, ic1 = {ic_[2], ic_[3]}, k0 = {k_[0], k_[1]}, k1 = {k_[2], k_[3]};
            const f32x2_t ka0 = {ka[0], ka[1]}, ka1 = {ka[2], ka[3]}, om0 = {oma[0], oma[1]}, om1 = {oma[2], oma[3]};
            const f32x2_t bb0 = kk0 * ic0, bb1 = kk1 * ic1;
            const f32x2_t kd0 = k0 * (om0 + ic0 * ka0), kd1 = k1 * (om1 + ic1 * ka1);
            b4 = make_float4(bb0.x, bb0.y, bb1.x, bb1.y); kd4 = make_float4(kd0.x, kd0.y, kd1.x, kd1.y);
        }
        *(float4*)(dst) = make_float4(kk_[0], kk_[1], kk_[2], kk_[3]);
        *(float4*)(dst + 64) = w4;
        *(float4*)(dst + 128) = b4;
        *(float4*)(dst + 192) = kd4;
        *(float4*)(dst + 256) = make_float4(r_[0], r_[1], r_[2], r_[3]);
        { const int t6 = tid & 63; float* dv = buf + (nb * SCH + (t6 >> 2)) * SROW + 320 + (t6 & 3) * 4; *(float4*)dv = make_float4(bflo(g_v.x), bfhi(g_v.x), bflo(g_v.y), bfhi(g_v.y)); }
    };
    __syncthreads();
    gload(sA, 0); swrite(sA, 0);
    gload(sA, 1);
    __syncthreads();
    __builtin_amdgcn_s_setprio(3);
    typedef float f32x2 __attribute__((ext_vector_type(2)));
    f32x2 Sa = {0.f, 0.f}, Sb = {0.f, 0.f};
    const int mycg = lane & 15;
    const bool b3 = (mycg & 8) != 0, b2 = (mycg & 4) != 0, b1 = (mycg & 2) != 0, b0 = (mycg & 1) != 0;
    constexpr int NCH = LK / SCH;
    auto body = [&](int ch, SSet& ld, const SSet& wr) {
        const int cur = ch & 1;
        gload(ld, ch + 2 < NCH ? ch + 2 : NCH - 1);
        const float* bp = buf + cur * SCH * SROW;
        float yp[SCH];
        float4 kk = *(const float4*)(bp + cg4), w = *(const float4*)(bp + 64 + cg4), bb = *(const float4*)(bp + 128 + cg4);
        float4 kd = *(const float4*)(bp + 192 + cg4), r = *(const float4*)(bp + 256 + cg4);
        float vv = bp[320 + lr];
#pragma unroll
        for (int st = 0; st < SCH; st++) {
            const float* qn = bp + (st + 1 < SCH ? st + 1 : st) * SROW;
            const float4 nkk = *(const float4*)(qn + cg4), nw = *(const float4*)(qn + 64 + cg4), nbb = *(const float4*)(qn + 128 + cg4);
            const float4 nkd = *(const float4*)(qn + 192 + cg4), nr = *(const float4*)(qn + 256 + cg4);
            const float nvv = qn[320 + lr];
            const f32x2 vv2 = {vv, vv};
            const f32x2 pr = Sa * f32x2{kk.x, kk.y} + Sb * f32x2{kk.z, kk.w};
            const f32x2 aa = Sa * f32x2{w.x, w.y} + vv2 * f32x2{kd.x, kd.y};
            const f32x2 ab = Sb * f32x2{w.z, w.w} + vv2 * f32x2{kd.z, kd.w};
            const float sk = rowsum16(pr.x + pr.y);
            const f32x2 sk2 = {sk, sk};
            Sa = aa - sk2 * f32x2{bb.x, bb.y};
            Sb = ab - sk2 * f32x2{bb.z, bb.w};
            const f32x2 py = Sa * f32x2{r.x, r.y} + Sb * f32x2{r.z, r.w};
            yp[st] = py.x + py.y;
            kk = nkk; w = nw; bb = nbb; kd = nkd; r = nr; vv = nvv;
        }
        float t8[8], t4[4], t2[2];
#pragma unroll
        for (int j = 0; j < 8; j++)
            asm volatile("v_add_f32_dpp %0, %1, %1 row_ror:8 row_mask:0xf bank_mask:0x3\n\tv_add_f32_dpp %0, %2, %2 row_ror:8 row_mask:0xf bank_mask:0xc"
                         : "=&v"(t8[j]) : "v"(yp[j]), "v"(yp[8 + j]));
#pragma unroll
        for (int j = 0; j < 4; j++)
            asm volatile("v_add_f32_dpp %0, %1, %1 row_half_mirror row_mask:0xf bank_mask:0x5\n\tv_add_f32_dpp %0, %2, %2 row_half_mirror row_mask:0xf bank_mask:0xa"
                         : "=&v"(t4[j]) : "v"(t8[j]), "v"(t8[4 + j]));
#pragma unroll
        for (int j = 0; j < 2; j++) { const float keep = b1 ? t4[2 + j] : t4[j], send = b1 ? t4[j] : t4[2 + j]; t2[j] = keep + dppf<0x4E>(send); }
        const float ykeep = (b0 ? t2[1] : t2[0]) + dppf<0xB1>(b0 ? t2[0] : t2[1]);
        ybuf[cur * SCH * 16 + mycg * 16 + lr] = ykeep;
        swrite(wr, cur ^ 1);
        __syncthreads();
        if (ch * SCH >= CTXL || need_ctx_out) {
            const unsigned yoff = (unsigned)(chunk_row0(ch) + sdir * st_s) * 1024u + (unsigned)(h * 64 + i0 + (tid & 15)) * 2u;
            *(bf16_t*)((char*)Y + (size_t)d * NROW * 1024 + yoff) = f2bf(ybuf[cur * SCH * 16 + st_s * 16 + (tid & 15)]);
        }
    };
#pragma unroll 1
    for (int ch = 0; ch < NCH; ch += 2) { body(ch, sB, sA); body(ch + 1, sA, sB); }
    __builtin_amdgcn_s_setprio(0);
}

constexpr int ATT_SMEM = 2 * 64 * 64 * 2 + 2 * 64 * 64 * 2;

__device__ __forceinline__ void attn_item(const P& p, int b, int kvh, int qpos0, int key_begin, int key_end, float cexp, float mexp, char* smem) {
    const bf16_t* Ks = (const bf16_t*)smem;
    const bf16_t* Vs = Ks + 2 * 64 * 64;
    const bf16_t* Q = (const bf16_t*)(p.ws + OFF_Q);
    bf16_t* O = (bf16_t*)(p.ws + OFF_AO);
    const bf16_t* kbase = (const bf16_t*)(p.ws + OFF_K) + (size_t)((b * 2 + kvh) * LK) * 64;
    const bf16_t* vbase = (const bf16_t*)(p.ws + OFF_VT) + (size_t)((b * 2 + kvh) * 64) * LK;
    const int tid = otid(), lane = tid & 63, wid = tid >> 6, head = kvh * 4 + wid, l31 = lane & 31, hh = lane >> 5;
    const size_t rowoff = ((size_t)((b * 8 + head) * LK + qpos0 + l31)) * 64;
    const float nm = __builtin_bit_cast(float, __builtin_amdgcn_readfirstlane(__builtin_bit_cast(int, -mexp)));
    bf16x8 qa[4], qb[4];
#pragma unroll
    for (int s = 0; s < 4; s++) { qa[s] = *(const bf16x8*)(Q + rowoff + 16 * s + hh * 8); qb[s] = *(const bf16x8*)(Q + rowoff + 32 * 64 + 16 * s + hh * 8); }
    f32x16 oa0, oa1, ob0, ob1;
#pragma unroll
    for (int i = 0; i < 16; i++) { oa0[i] = 0.f; oa1[i] = 0.f; ob0[i] = 0.f; ob1[i] = 0.f; }
    float lsa = 0.f, lsb = 0.f;
    const int wu = __builtin_amdgcn_readfirstlane(wid);
    auto stage = [&](int nb, int key0) {
#pragma unroll
        for (int i = 0; i < 2; i++) {
            const int piece = wu * 2 + i, row = piece * 8 + (lane >> 3), kc = (lane & 7) ^ ((row >> 1) & 7);
            __builtin_amdgcn_global_load_lds((const GAS void*)(kbase + (size_t)(key0 + row) * 64 + kc * 8), (LDSAS void*)(smem + nb * 8192 + piece * 1024), 16, 0, 0);
            __builtin_amdgcn_global_load_lds((const GAS void*)(vbase + (size_t)row * LK + key0 + kc * 8), (LDSAS void*)(smem + 16384 + nb * 8192 + piece * 1024), 16, 0, 0);
        }
    };
    const int fsw = (l31 >> 1) & 7;
    __syncthreads();
    stage(0, key_begin);
    __syncthreads();
    const int nt = (key_end - key_begin) / 64;
    for (int t = 0; t < nt; t++) {
        const int cur = t & 1;
        if (t + 1 < nt) stage(cur ^ 1, key_begin + (t + 1) * 64);
#pragma unroll
        for (int kb = 0; kb < 2; kb++) {
            f32x16 sa, sb;
#pragma unroll
            for (int i = 0; i < 16; i++) { sa[i] = nm; sb[i] = nm; }
#pragma unroll
            for (int s = 0; s < 4; s++) {
                const bf16x8 a = *(const bf16x8*)(Ks + (cur * 64 + kb * 32 + l31) * 64 + (((2 * s + hh) ^ fsw) << 3));
                sa = __builtin_amdgcn_mfma_f32_32x32x16_bf16(a, qa[s], sa, 0, 0, 0);
                sb = __builtin_amdgcn_mfma_f32_32x32x16_bf16(a, qb[s], sb, 0, 0, 0);
            }
#pragma unroll
            for (int i = 0; i < 16; i++) {
                sa[i] = __builtin_amdgcn_exp2f(sa[i]); sb[i] = __builtin_amdgcn_exp2f(sb[i]);
                lsa += sa[i]; lsb += sb[i];
            }
#pragma unroll
            for (int ss = 0; ss < 2; ss++) {
                u32x4 pa, pb;
#pragma unroll
                for (int j = 0; j < 4; j++) {
                    pa[j] = cvtpk(sa[8 * ss + 2 * j], sa[8 * ss + 2 * j + 1]);
                    pb[j] = cvtpk(sb[8 * ss + 2 * j], sb[8 * ss + 2 * j + 1]);
                }
                const bf16x8 pfa = __builtin_bit_cast(bf16x8, pa), pfb = __builtin_bit_cast(bf16x8, pb);
                const int kofs = ((4 * kb + 2 * ss + hh) ^ fsw) << 3;
                {
                    const bf16x8 va = *(const bf16x8*)(Vs + (cur * 64 + l31) * 64 + kofs);
                    oa0 = __builtin_amdgcn_mfma_f32_32x32x16_bf16(va, pfa, oa0, 0, 0, 0);
                    ob0 = __builtin_amdgcn_mfma_f32_32x32x16_bf16(va, pfb, ob0, 0, 0, 0);
                }
                {
                    const bf16x8 va = *(const bf16x8*)(Vs + (cur * 64 + 32 + l31) * 64 + kofs);
                    oa1 = __builtin_amdgcn_mfma_f32_32x32x16_bf16(va, pfa, oa1, 0, 0, 0);
                    ob1 = __builtin_amdgcn_mfma_f32_32x32x16_bf16(va, pfb, ob1, 0, 0, 0);
                }
            }
        }
        __syncthreads();
    }
    lsa += __shfl_xor(lsa, 32); lsb += __shfl_xor(lsb, 32);
    const float ia = 1.f / lsa, ib = 1.f / lsb;
    bf16_t* orow = O + rowoff;
#pragma unroll
    for (int g4 = 0; g4 < 4; g4++) {
        uint2 w0, w1, x0, x1;
        w0.x = cvtpk(oa0[4 * g4] * ia, oa0[4 * g4 + 1] * ia); w0.y = cvtpk(oa0[4 * g4 + 2] * ia, oa0[4 * g4 + 3] * ia);
        w1.x = cvtpk(oa1[4 * g4] * ia, oa1[4 * g4 + 1] * ia); w1.y = cvtpk(oa1[4 * g4 + 2] * ia, oa1[4 * g4 + 3] * ia);
        x0.x = cvtpk(ob0[4 * g4] * ib, ob0[4 * g4 + 1] * ib); x0.y = cvtpk(ob0[4 * g4 + 2] * ib, ob0[4 * g4 + 3] * ib);
        x1.x = cvtpk(ob1[4 * g4] * ib, ob1[4 * g4 + 1] * ib); x1.y = cvtpk(ob1[4 * g4 + 2] * ib, ob1[4 * g4 + 3] * ib);
        *(uint2*)(orow + 8 * g4 + 4 * hh) = w0;
        *(uint2*)(orow + 32 + 8 * g4 + 4 * hh) = w1;
        *(uint2*)(orow + 32 * 64 + 8 * g4 + 4 * hh) = x0;
        *(uint2*)(orow + 32 * 64 + 32 + 8 * g4 + 4 * hh) = x1;
    }
}

__device__ __forceinline__ void convert_row_fp6(const float* __restrict__ src, unsigned char* __restrict__ dst, float* __restrict__ sc, int row, int lane) {
    const float4* sp = (const float4*)(src + (size_t)row * D) + lane * 4;
    float4 v[4]; float am = 0.f;
#pragma unroll
    for (int j = 0; j < 4; j++) { v[j] = sp[j]; am = fmaxf(am, fmaxf(fmaxf(fabsf(v[j].x), fabsf(v[j].y)), fmaxf(fabsf(v[j].z), fabsf(v[j].w)))); }
    am = wave_max(am);
    const float q = (am > 0.f) ? 7.5f / am : 1.f;
    unsigned c[16];
#pragma unroll
    for (int j = 0; j < 4; j++) {
        const float e4[4] = {v[j].x * q, v[j].y * q, v[j].z * q, v[j].w * q};
#pragma unroll
        for (int k = 0; k < 4; k++) {
            const unsigned bits = __float_as_uint(e4[k]);
            const float a = fabsf(e4[k]);
            int e = (int)((bits >> 23) & 255u) - 127; e = e < 0 ? 0 : (e > 2 ? 2 : e);
            const float inv_step = __uint_as_float((unsigned)(130 - e) << 23);
            int code = (int)rintf(a * inv_step) + 8 * e; code = code > 31 ? 31 : code;
            c[4 * j + k] = (unsigned)code | ((bits >> 31) << 5);
        }
    }
    unsigned o[3];
    o[0] = c[0] | (c[1] << 6) | (c[2] << 12) | (c[3] << 18) | (c[4] << 24) | (c[5] << 30);
    o[1] = (c[5] >> 2) | (c[6] << 4) | (c[7] << 10) | (c[8] << 16) | (c[9] << 22) | (c[10] << 28);
    o[2] = (c[10] >> 4) | (c[11] << 2) | (c[12] << 8) | (c[13] << 14) | (c[14] << 20) | (c[15] << 26);
    U3 st; st.x = o[0]; st.y = o[1]; st.z = o[2];
    *(U3*)(dst + (size_t)row * EROW + lane * 12) = st;
    if (lane == 0) sc[row] = (am > 0.f) ? am * (1.f / 7.5f) : 1.f;
}
__device__ __forceinline__ void phase_expert_convert(const P& p, int l, int bid, int nblk) {
    const int lane = otid() & 63, gw = bid * 4 + (otid() >> 6), nw = nblk * 4;
    const float* su = p.eu + (size_t)l * NEXP * D; const float* sv = p.ev + (size_t)l * NEXP * D;
    for (int r = gw; r < 2 * NEXP; r += nw) {
        if (r < NEXP) convert_row_fp6(su, (unsigned char*)(p.ws + OFF_EUB), (float*)(p.ws + OFF_USC), r, lane);
        else convert_row_fp6(sv, (unsigned char*)(p.ws + OFF_EVB), (float*)(p.ws + OFF_VSC), r - NEXP, lane);
    }
}

__device__ __forceinline__ void phase_rwkv_out(const P& p, int l, int nrows, int bid, int nblk) {
    const bf16_t* Y = (const bf16_t*)(p.ws + OFF_Y);
    const bf16_t* E = (const bf16_t*)(p.ws + OFF_E);
    const bf16_t* GATE = (const bf16_t*)(p.ws + OFF_GATE);
    const float* BON = (const float*)(p.ws + OFF_BON);
    bf16_t* RWO = (bf16_t*)(p.ws + OFF_RWO);
    const int lane = otid() & 63, gw = bid * 4 + (otid() >> 6), nw = nblk * 4;
    const int c0 = lane * 8;
    float lw[8], lb[8];
#pragma unroll
    for (int j = 0; j < 8; j++) { lw[j] = p.ln_w[l * 512 + c0 + j]; lb[j] = p.ln_b[l * 512 + c0 + j]; }
    for (int row = gw; row < nrows; row += nw) {
        const size_t o = (size_t)row * 512 + c0;
        const uint4 y0 = *(const uint4*)(Y + o), y1 = *(const uint4*)(Y + (size_t)NROW * 512 + o);
        const uint4 vv = *(const uint4*)(E + 2 * (SZ_E1 / 2) + o), gg = *(const uint4*)(GATE + o);
        const float bon = BON[(size_t)row * 8 + (lane >> 3)];
        float y[8] = {bflo(y0.x) + bflo(y1.x), bfhi(y0.x) + bfhi(y1.x), bflo(y0.y) + bflo(y1.y), bfhi(y0.y) + bfhi(y1.y),
                      bflo(y0.z) + bflo(y1.z), bfhi(y0.z) + bfhi(y1.z), bflo(y0.w) + bflo(y1.w), bfhi(y0.w) + bfhi(y1.w)};
        const float v[8] = {bflo(vv.x), bfhi(vv.x), bflo(vv.y), bfhi(vv.y), bflo(vv.z), bfhi(vv.z), bflo(vv.w), bfhi(vv.w)};
        const float g[8] = {bflo(gg.x), bfhi(gg.x), bflo(gg.y), bfhi(gg.y), bflo(gg.z), bfhi(gg.z), bflo(gg.w), bfhi(gg.w)};
        float s = 0.f;
#pragma unroll
        for (int j = 0; j < 8; j++) s += y[j];
        s += __shfl_xor(s, 1); s += __shfl_xor(s, 2); s += __shfl_xor(s, 4);
        const float mu = s * (1.f / 64.f);
        float q = 0.f;
#pragma unroll
        for (int j = 0; j < 8; j++) { y[j] -= mu; q += y[j] * y[j]; }
        q += __shfl_xor(q, 1); q += __shfl_xor(q, 2); q += __shfl_xor(q, 4);
        const float rs = rsqrtf(q * (1.f / 64.f) + 64e-5f);
        float outv[8];
#pragma unroll
        for (int j = 0; j < 8; j++) outv[j] = (y[j] * rs * lw[j] + lb[j] + bon * v[j]) * g[j];
        store8bf(RWO + o, outv);
    }
}

__device__ __forceinline__ void phase_outproj(const P& p, int l, int nrows, const float* xlat, const float* xctx, char* smem, int bid, int nblk) {
    AMix ap{(const bf16_t*)(p.ws + OFF_AO), (const bf16_t*)(p.ws + OFF_RWO)};
    EpiOutProj epi{xlat, xctx, (bf16_t*)(p.ws + OFF_XB), (float*)(p.ws + OFF_CTXS), (const float*)(p.ws + OFF_MOD) + (size_t)l * 5 * 6144 + 2 * 1024};
    const bf16_t* Bt = (const bf16_t*)(p.ws + OFF_WOUT) + (size_t)l * D * D;
    const int MT = nrows / 128;
    for (int it = xcd_vbid(bid, nblk); it < MT * 8; it += nblk) gemm_tile(ap, Bt, D, D, (it >> 3) * 128, (it & 7) * 128, smem, epi);
}

__device__ __forceinline__ void phase_scores(const P& p, int l, int nrows, char* smem, int bid, int nblk) {
    ARow ap{(const bf16_t*)(p.ws + OFF_H), D};
    EpiTopk epi{(float*)(p.ws + OFF_TOPV), (int*)(p.ws + OFF_TOPI)};
    const bf16_t* Bt = (const bf16_t*)(p.ws + OFF_WST) + (size_t)l * 2048 * D;
    const int MT = nrows / 128;
    for (int it = xcd_vbid(bid, nblk); it < MT * 16; it += nblk) {
        const int g = it >> 7, r = it & 127, nt = r >> 3, mt = g * 8 + (r & 7);
        gemm_tile(ap, Bt, D, D, mt * 128, nt * 128, smem, epi);
    }
}

constexpr int PEER_TOK = 16, NSLAB = 16, SLAB_SHIFT = 10, SOFF_LD = 20;
constexpr int PEER_SMEM = PEER_TOK * 128 * 4 * 4 + PEER_TOK * SOFF_LD * 4;

template <int NT>
__device__ __forceinline__ void peer_group(const P& p, int l, int row0, int ntok, char* smem) {
    int* uidx = (int*)smem;
    float* ugate = (float*)(smem + PEER_TOK * 128 * 4);
    int* sidx = (int*)(smem + 2 * PEER_TOK * 128 * 4);
    float* sgate = (float*)(smem + 3 * PEER_TOK * 128 * 4);
    int* soff = (int*)(smem + 4 * PEER_TOK * 128 * 4);
    const float* TV = (const float*)(p.ws + OFF_TOPV);
    const int* TI = (const int*)(p.ws + OFF_TOPI);
    const bf16_t* H = (const bf16_t*)(p.ws + OFF_H);
    const float* mod = (const float*)(p.ws + OFF_MOD) + (size_t)l * 5 * 6144;
    const unsigned char* EU = (const unsigned char*)(p.ws + OFF_EUB);
    const unsigned char* EV = (const unsigned char*)(p.ws + OFF_EVB);
    const float* USC = (const float*)(p.ws + OFF_USC);
    const float* VSC = (const float*)(p.ws + OFF_VSC);
    float* ctxs = (float*)(p.ws + OFF_CTXS);
    const int tid = otid(), lane = tid & 63, wid = tid >> 6;
    const __amdgpu_buffer_rsrc_t rsu = __builtin_amdgcn_make_buffer_rsrc((void*)EU, (short)0, NEXP * EROW, 0x00020000);
    const __amdgpu_buffer_rsrc_t rsv = __builtin_amdgcn_make_buffer_rsrc((void*)EV, (short)0, NEXP * EROW, 0x00020000);
    const unsigned l12 = (unsigned)lane * 12u;
    __syncthreads();
    {
        const int tok = tid >> 3, hd = tid & 7, row = row0 + tok;
        if (tok < ntok) {
            const float* pv1 = TV + ((size_t)row * 16 + hd * 2) * 16; const float* pv2 = pv1 + 16;
            const int* pi1 = TI + ((size_t)row * 16 + hd * 2) * 16; const int* pi2 = pi1 + 16;
            float v1[16], v2[16];
#pragma unroll
            for (int j = 0; j < 4; j++) {
                float4 a = ((const float4*)pv1)[j], c = ((const float4*)pv2)[j];
                v1[4 * j] = a.x; v1[4 * j + 1] = a.y; v1[4 * j + 2] = a.z; v1[4 * j + 3] = a.w;
                v2[4 * j] = c.x; v2[4 * j + 1] = c.y; v2[4 * j + 2] = c.z; v2[4 * j + 3] = c.w;
            }
            unsigned top[16];
#pragma unroll
            for (int j = 0; j < 16; j++) top[j] = 0u;
#pragma unroll
            for (int a = 0; a < 16; a++)
#pragma unroll
                for (int c = 0; c < 16; c++)
                    if ((a + 1) * (c + 1) <= 16) ins16(top, (ford(v1[a] + v2[c]) & 0xFFFFFF00u) | (unsigned)(255 - (a * 16 + c)));
            float sc[16]; float sum = 0.f;
            const float m = funord(top[0] & 0xFFFFFF00u);
#pragma unroll
            for (int j = 0; j < 16; j++) { sc[j] = __expf(funord(top[j] & 0xFFFFFF00u) - m); sum += sc[j]; }
            const float inv = 1.f / sum;
#pragma unroll
            for (int j = 0; j < 16; j++) {
                const int code = 255 - (int)(top[j] & 255u);
                uidx[tok * 128 + hd * 16 + j] = pi1[code >> 4] * 128 + pi2[code & 15];
                ugate[tok * 128 + hd * 16 + j] = sc[j] * inv;
            }
        }
    }
    __syncthreads();
#pragma unroll 1
    for (int tk = 0; tk < NT; tk++) {
        const int tok = tk * 4 + wid;
        if (tok < ntok) {
            const int i0 = uidx[tok * 128 + lane], i1 = uidx[tok * 128 + 64 + lane];
            const float g0 = ugate[tok * 128 + lane], g1 = ugate[tok * 128 + 64 + lane];
            const int s0 = i0 >> SLAB_SHIFT, s1 = i1 >> SLAB_SHIFT;
            int base = 0, pos0 = 0, pos1 = 0;
            for (int s = 0; s < NSLAB; s++) {
                const unsigned long long m0 = __ballot(s0 == s), m1 = __ballot(s1 == s);
                const int r0 = __builtin_amdgcn_mbcnt_hi((unsigned)(m0 >> 32), __builtin_amdgcn_mbcnt_lo((unsigned)m0, 0u));
                const int r1 = __builtin_amdgcn_mbcnt_hi((unsigned)(m1 >> 32), __builtin_amdgcn_mbcnt_lo((unsigned)m1, 0u));
                const int c0 = __popcll(m0);
                if (s0 == s) pos0 = base + r0;
                if (s1 == s) pos1 = base + c0 + r1;
                if (lane == 0) soff[tok * SOFF_LD + s] = base;
                base += c0 + __popcll(m1);
            }
            if (lane == 0) soff[tok * SOFF_LD + NSLAB] = base;
            sidx[tok * 128 + pos0] = i0; sidx[tok * 128 + pos1] = i1;
            sgate[tok * 128 + pos0] = g0; sgate[tok * 128 + pos1] = g1;
        }
    }
    __syncthreads();
    float* sdot = ugate;
    {
        bf2_t hp[NT][8];
#pragma unroll
        for (int tk = 0; tk < NT; tk++) {
            const int row = row0 + tk * 4 + wid;
            const uint4 h0 = ((const uint4*)(H + (size_t)row * D))[2 * lane], h1 = ((const uint4*)(H + (size_t)row * D))[2 * lane + 1];
            hp[tk][0] = __builtin_bit_cast(bf2_t, h0.x); hp[tk][1] = __builtin_bit_cast(bf2_t, h0.y); hp[tk][2] = __builtin_bit_cast(bf2_t, h0.z); hp[tk][3] = __builtin_bit_cast(bf2_t, h0.w);
            hp[tk][4] = __builtin_bit_cast(bf2_t, h1.x); hp[tk][5] = __builtin_bit_cast(bf2_t, h1.y); hp[tk][6] = __builtin_bit_cast(bf2_t, h1.z); hp[tk][7] = __builtin_bit_cast(bf2_t, h1.w);
        }
        U3 ua[8], ub[8];
        auto issue = [&](U3 (&dst)[8], int tk, int r) {
            const int* ip = sidx + (tk * 4 + wid) * 128 + 8 * r;
#pragma unroll
            for (int q = 0; q < 8; q++) { const u32x3 t = __builtin_amdgcn_raw_buffer_load_b96(rsu, __umul24((unsigned)ip[q], (unsigned)EROW) + l12, 0, 0); dst[q].x = t.x; dst[q].y = t.y; dst[q].z = t.z; }
        };
        auto reduce = [&](const U3 (&src)[8], int tk, int r) {
            float a[8];
#pragma unroll
            for (int q = 0; q < 8; q += 2) {
                u32x6 pk; pk[0] = src[q].x; pk[1] = src[q].y; pk[2] = src[q].z; pk[3] = src[q + 1].x; pk[4] = src[q + 1].y; pk[5] = src[q + 1].z;
                const bf16x32 g = __builtin_amdgcn_cvt_scalef32_pk32_bf16_fp6(pk, 1.0f);
                float a0 = 0.f, a1 = 0.f;
#pragma unroll
                for (int d = 0; d < 8; d++) {
                    bf2_t x0, x1; x0[0] = g[2 * d]; x0[1] = g[2 * d + 1]; x1[0] = g[16 + 2 * d]; x1[1] = g[17 + 2 * d];
                    a0 = __builtin_amdgcn_fdot2_f32_bf16(x0, hp[tk][d], a0, false);
                    a1 = __builtin_amdgcn_fdot2_f32_bf16(x1, hp[tk][d], a1, false);
                }
                a[q] = a0; a[q + 1] = a1;
            }
            const bool b0 = lane & 1, b1 = lane & 2, b2 = lane & 4;
            float t4[4], t2[2];
#pragma unroll
            for (int j = 0; j < 4; j++) { const float keep = b2 ? a[4 + j] : a[j], send = b2 ? a[j] : a[4 + j]; t4[j] = keep + dppf<0x141>(send); }
#pragma unroll
            for (int j = 0; j < 2; j++) { const float keep = b1 ? t4[2 + j] : t4[j], send = b1 ? t4[j] : t4[2 + j]; t2[j] = keep + dppf<0x4E>(send); }
            float v = (b0 ? t2[1] : t2[0]) + dppf<0xB1>(b0 ? t2[0] : t2[1]);
            v += dppf<0x128>(v);
            v += __builtin_bit_cast(float, __builtin_amdgcn_ds_swizzle(__builtin_bit_cast(int, v), 0x401F));
            v += __shfl_xor(v, 32);
            if (lane < 8) sdot[(tk * 4 + wid) * 128 + 8 * r + lane] = v;
        };
        if (NT > 1) {
            issue(ua, 0, 0);
#pragma unroll 1
            for (int r = 0; r < 16; r++) {
#pragma unroll
                for (int tk = 0; tk < NT; tk++) {
                    const int ntk = (tk + 1) & (NT - 1), nr = (tk == NT - 1) ? ((r < 15) ? r + 1 : r) : r;
                    if ((tk & 1) == 0) { issue(ub, ntk, nr); reduce(ua, tk, r); }
                    else { issue(ua, ntk, nr); reduce(ub, tk, r); }
                }
            }
        } else {
#pragma unroll 1
            for (int r = 0; r < 16; r++) { issue(ua, 0, r); reduce(ua, 0, r); }
        }
    }
    __syncthreads();
    for (int i = tid; i < PEER_TOK * 128; i += NTHR) {
        if ((i >> 7) < ntok) { const int ex = sidx[i]; const float d = sdot[i] * USC[ex]; sdot[i] = sgate[i] * 0.5f * d * (1.f + erff(d * 0.70710678118654752f)) * VSC[ex]; }
    }
    __syncthreads();
    {
        float acc[NT][16];
#pragma unroll
        for (int tk = 0; tk < NT; tk++)
#pragma unroll
            for (int j = 0; j < 16; j++) acc[tk][j] = 0.f;
        U3 ua[8], ub[8];
        auto issue = [&](U3 (&dst)[8], int tk, int r) {
            const int* ip = sidx + (tk * 4 + wid) * 128 + 8 * r;
#pragma unroll
            for (int q = 0; q < 8; q++) { const u32x3 t = __builtin_amdgcn_raw_buffer_load_b96(rsv, __umul24((unsigned)ip[q], (unsigned)EROW) + l12, 0, 0); dst[q].x = t.x; dst[q].y = t.y; dst[q].z = t.z; }
        };
        auto accum = [&](const U3 (&src)[8], float (&ac)[16], int tk, int r) {
            const float* cp = sdot + (tk * 4 + wid) * 128 + 8 * r;
#pragma unroll
            for (int q = 0; q < 8; q += 2) {
                u32x6 pk; pk[0] = src[q].x; pk[1] = src[q].y; pk[2] = src[q].z; pk[3] = src[q + 1].x; pk[4] = src[q + 1].y; pk[5] = src[q + 1].z;
                const f32x32 f = __builtin_amdgcn_cvt_scalef32_pk32_f32_fp6(pk, 1.0f);
                const float c0 = cp[q], c1 = cp[q + 1];
#pragma unroll
                for (int j = 0; j < 16; j++) ac[j] += c0 * f[j];
#pragma unroll
                for (int j = 0; j < 16; j++) ac[j] += c1 * f[16 + j];
            }
        };
        if (NT > 1) {
            issue(ua, 0, 0);
#pragma unroll 1
            for (int r = 0; r < 16; r++) {
#pragma unroll
                for (int tk = 0; tk < NT; tk++) {
                    const int ntk = (tk + 1) & (NT - 1), nr = (tk == NT - 1) ? ((r < 15) ? r + 1 : r) : r;
                    if ((tk & 1) == 0) { issue(ub, ntk, nr); accum(ua, acc[tk], tk, r); }
                    else { issue(ua, ntk, nr); accum(ub, acc[tk], tk, r); }
                }
            }
        } else {
#pragma unroll 1
            for (int r = 0; r < 16; r++) { issue(ua, 0, r); accum(ua, acc[0], 0, r); }
        }
#pragma unroll
        for (int tk = 0; tk < NT; tk++) {
            const int tok = tk * 4 + wid;
            if (tok < ntok) {
                const int row = row0 + tok;
                int b, pos; bool isctx; rowinfo(row, b, pos, isctx);
                const int sm = isctx ? 4 : b;
                float* xr = (isctx ? ctxs + (size_t)(row - NLAT) * D : p.out + (size_t)row * D) + lane * 16;
                const float* gf = mod + sm * 6144 + 5 * 1024 + lane * 16;
                float xin[16];
                if (isctx) {
#pragma unroll
                    for (int j = 0; j < 4; j++) { const float4 t4 = ((const float4*)xr)[j]; xin[4 * j] = t4.x; xin[4 * j + 1] = t4.y; xin[4 * j + 2] = t4.z; xin[4 * j + 3] = t4.w; }
                } else {
                    const uint4* xb = (const uint4*)((const bf16_t*)(p.ws + OFF_XB) + (size_t)row * D + lane * 16);
                    unpack8(xb[0], xin); unpack8(xb[1], xin + 8);
                }
                float xs[16]; float ss = 0.f;
#pragma unroll
                for (int j = 0; j < 4; j++) {
                    float4 x = make_float4(xin[4 * j], xin[4 * j + 1], xin[4 * j + 2], xin[4 * j + 3]); const float4 g = ((const float4*)gf)[j];
                    x.x += g.x * acc[tk][4 * j]; x.y += g.y * acc[tk][4 * j + 1]; x.z += g.z * acc[tk][4 * j + 2]; x.w += g.w * acc[tk][4 * j + 3];
                    ((float4*)xr)[j] = x;
                    xs[4 * j] = x.x; xs[4 * j + 1] = x.y; xs[4 * j + 2] = x.z; xs[4 * j + 3] = x.w;
                    ss += x.x * x.x + x.y * x.y + x.z * x.z + x.w * x.w;
                }
                if (l == 0) {
                    const float rinv = rsqrtf(wave_sum_dpp(ss) * (1.f / D) + 1e-6f);
                    const float* gn = p.norm_mix + D + lane * 16;
                    const float* sh = mod + 5 * 6144 + sm * 6144 + lane * 16; const float* sc = sh + 1024;
                    float hv[16];
#pragma unroll
                    for (int j = 0; j < 16; j++) hv[j] = xs[j] * rinv * gn[j] * (1.f + sc[j]) + sh[j];
                    bf16_t* hr = (bf16_t*)(p.ws + OFF_H) + (size_t)row * D + lane * 16;
                    store8bf(hr, hv); store8bf(hr + 8, hv + 8);
                }
            }
        }
    }
}

__device__ __forceinline__ void phase_peer(const P& p, int l, int nrows, char* smem, int bid, int nblk) {
    for (int g = bid; g < NLAT / PEER_TOK; g += nblk) peer_group<4>(p, l, g * PEER_TOK, PEER_TOK, smem);
    if (nrows > NLAT) {
        const int per = 4;
        for (int g = bid; g < NCTX / per; g += nblk) peer_group<1>(p, l, NLAT + g * per, per, smem);
    }
}

#define XB_TMO      128
#define XB_XCNT(j)  (256  + 64 * (j))
#define XB_XSUB(j)  (1280 + 64 * (j))
#define XB_XGEN(j)  (2304 + 64 * (j))
#define XB_TOP      3328
#define XB_TOPGEN   3392
#define XCD_BAR_WORDS 3456
#define XB_SPIN_CAP (1u << 22)
#define LAS __attribute__((address_space(3)))
__device__ __forceinline__ unsigned xb_ld(unsigned* p) { return __hip_atomic_load(p, __ATOMIC_RELAXED, __HIP_MEMORY_SCOPE_AGENT); }
__device__ __forceinline__ unsigned xb_add(unsigned* p, unsigned v) { return __hip_atomic_fetch_add(p, v, __ATOMIC_RELAXED, __HIP_MEMORY_SCOPE_AGENT); }
__device__ __forceinline__ unsigned xb_xcc_id() { return (unsigned)__builtin_amdgcn_s_getreg((3 << 11) | 20) & 0xFu; }
#define XB_SPIN(cond, bar) do { unsigned _sp = 0; while (cond) { __builtin_amdgcn_s_sleep(1); \
    if ((++_sp & 255u) == 0u) { if (xb_ld(&(bar)[XB_TMO])) break; if (_sp > XB_SPIN_CAP) { atomicAdd(&(bar)[XB_TMO], 1u); break; } } } } while (0)
struct XcdBarrier { unsigned* bar; unsigned x; volatile LAS unsigned* st; };
__device__ __forceinline__ XcdBarrier xcd_barrier_post(unsigned* bar, volatile LAS unsigned* st) {
    XcdBarrier b; b.bar = bar; b.x = xb_xcc_id(); b.st = st;
    if (threadIdx.x == 0) (void)xb_add(&bar[XB_XCNT(b.x)], 1u);
    return b;
}
__device__ __forceinline__ void xcd_barrier_complete(unsigned* bar, unsigned x, unsigned& nloc, unsigned& nx) {
    const unsigned G = gridDim.x * gridDim.y * gridDim.z;
    unsigned sum, cnt, mine, sp = 0u;
    for (;;) {
        sum = 0u; cnt = 0u; mine = 0u;
#pragma unroll
        for (unsigned j = 0; j < 16; ++j) { const unsigned c = xb_ld(&bar[XB_XCNT(j)]); sum += c; cnt += (c > 0u) ? 1u : 0u; mine = (j == x) ? c : mine; }
        if (sum == G) break;
        __builtin_amdgcn_s_sleep(1);
        if ((++sp & 255u) == 0u) { if (xb_ld(&bar[XB_TMO])) break; if (sp > XB_SPIN_CAP) { atomicAdd(&bar[XB_TMO], 1u); break; } }
    }
    nloc = mine > 0u ? mine : 1u; nx = cnt > 0u ? cnt : 1u;
}
__device__ __forceinline__ void xcd_barrier(const XcdBarrier& b) {
    asm volatile("s_waitcnt vmcnt(0)" ::: "memory");
    __syncthreads();
    if (threadIdx.x == 0) {
        unsigned* bar = b.bar;
        __builtin_amdgcn_s_waitcnt(0);
        unsigned nloc = b.st[0], nx = b.st[1];
        if (nloc == 0u) { xcd_barrier_complete(bar, b.x, nloc, nx); b.st[0] = nloc; b.st[1] = nx; }
        const unsigned old = xb_add(&bar[XB_XSUB(b.x)], 1u);
        const unsigned gen = old / nloc;
        if (old + 1u == (gen + 1u) * nloc) {
            __builtin_amdgcn_fence(__ATOMIC_RELEASE, "agent");
            asm volatile("s_waitcnt vmcnt(0)" ::: "memory");
            const unsigned og = xb_add(&bar[XB_TOP], 1u);
            const unsigned tg = og / nx;
            if (og + 1u == (tg + 1u) * nx) xb_add(&bar[XB_TOPGEN], 1u);
            else XB_SPIN(xb_ld(&bar[XB_TOPGEN]) == tg, bar);
            __builtin_amdgcn_fence(__ATOMIC_ACQUIRE, "agent");
            xb_add(&bar[XB_XGEN(b.x)], 1u);
            asm volatile("s_waitcnt vmcnt(0)" ::: "memory");
        } else {
            XB_SPIN(xb_ld(&bar[XB_XGEN(b.x)]) == gen, bar);
            __builtin_amdgcn_fence(__ATOMIC_ACQUIRE, "agent");
            asm volatile("s_waitcnt vmcnt(0)" ::: "memory");
        }
    }
    __syncthreads();
}

extern __shared__ __attribute__((aligned(16))) char dyn_smem[];

constexpr size_t OFF_CTR = WS_END;
constexpr size_t OFF_BAR = WS_END + 256;
constexpr size_t CTL_BYTES = OFF_LORAW - WS_END;
static_assert(OFF_LORAW >= WS_END + 256 + XCD_BAR_WORDS * 4, "control words overlap the LoRA weight copies");
constexpr size_t WS_END2 = OFF_LORAW + 2 * LORAW_L * 2;
constexpr int MEGA_SMEM = GEMM_SMEM + 16;

__device__ __forceinline__ void phase_scan_attn(const P& p, int l, bool need_ctx, char* smem, int bid, int nblk, unsigned* ctr) {
    if (nblk >= 256 && bid < 256) scan_item(p, l, (bid & 7) * 32 + (bid >> 3), need_ctx, smem);
    else if (nblk < 256) { for (int it = bid; it < 256; it += nblk) scan_item(p, l, it, need_ctx, smem); }
    const int lane = otid() & 63;
    const float gq = wave_max(fabsf(p.q_gain[l * 64 + lane])), gk = wave_max(fabsf(p.k_gain[l * 64 + lane]));
    const float cexp = 0.125f * 1.4426950408889634f;
    const float mexp = 8.f * gq * gk * 1.4426950408889634f;
    const int nlat = NB * 2 * (SEQ / 64), nctx = need_ctx ? NB * 2 * (CTXL / 64) : 0;
    int* slot = (int*)(smem + ATT_SMEM);
    for (;;) {
        __syncthreads();
        if (otid() == 0) *slot = (int)atomicAdd(ctr, 1u);
        __syncthreads();
        const int it = *slot;
        if (it >= nlat + nctx) break;
        if (it < nlat) {
            const int bk = it / (SEQ / 64), qt = it % (SEQ / 64);
            attn_item(p, bk >> 1, bk & 1, qt * 64, 0, LK, cexp, mexp, smem);
        } else {
            const int j = it - nlat, bk = j / (CTXL / 64), qt = j % (CTXL / 64);
            attn_item(p, bk >> 1, bk & 1, SEQ + qt * 64, SEQ, LK, cexp, mexp, smem);
        }
    }
}

typedef __attribute__((address_space(4))) const P* KP;
__device__ __forceinline__ P load_params() {
    KP q = (KP)__builtin_amdgcn_kernarg_segment_ptr();
    asm volatile("" : "+s"(q));
    P r;
    r.x = q->x; r.c = q->c; r.ctx = q->ctx; r.c_ctx = q->c_ctx; r.mod_w = q->mod_w; r.mod_b = q->mod_b; r.norm_mix = q->norm_mix; r.norm_ffn = q->norm_ffn;
    r.w_in = q->w_in; r.q_gain = q->q_gain; r.k_gain = q->k_gain; r.shift_taps = q->shift_taps; r.decay_base = q->decay_base; r.decay_up = q->decay_up;
    r.iclr_base = q->iclr_base; r.iclr_up = q->iclr_up; r.gate_up = q->gate_up; r.k_k = q->k_k; r.k_a = q->k_a; r.r_k = q->r_k; r.ln_w = q->ln_w; r.ln_b = q->ln_b;
    r.w_out = q->w_out; r.peer_query = q->peer_query; r.sk1 = q->sk1; r.sk2 = q->sk2; r.eu = q->eu; r.ev = q->ev; r.out = q->out; r.ws = q->ws;
    return r;
}
#define LP load_params()

__global__ void __launch_bounds__(NTHR, 2) k_mega(P p_unused) {
    cg::grid_group grid = cg::this_grid();
    char* smem = dyn_smem;
    const int bid = blockIdx.x, nblk = gridDim.x;
    char* const ws0 = LP.ws;
    volatile LAS unsigned* xst = (volatile LAS unsigned*)&dyn_smem[GEMM_SMEM];
    if (threadIdx.x == 0) { xst[0] = 0u; xst[1] = 0u; }
    __syncthreads();
    XcdBarrier xb = xcd_barrier_post((unsigned*)(ws0 + OFF_BAR), xst);
    xb.bar = nullptr;
    phase_prep(LP, smem, bid, nblk);
    grid.sync();
    phase_prep2(LP, bid, nblk);
    phase_ws(LP, smem, bid, nblk);
    { XcdBarrier xq = xb; xq.bar = (unsigned*)(LP.ws + OFF_BAR); { unsigned xx = xb.x; asm volatile("" : "+s"(xx)); xq.x = xx; } xcd_barrier(xq); }

    for (int l = 0; l < 2; l++) {
        const bool need_ctx = (l == 0);
        const int nrows2 = need_ctx ? NROW : NLAT;
        if (l == 0) {
            const P p = LP;
            phase_normmod<false>(p.x, p.ctx, p.norm_mix, (const float*)(p.ws + OFF_MOD), 0, 1, (bf16_t*)(p.ws + OFF_H), NROW, bid, nblk);
            { XcdBarrier xq = xb; xq.bar = (unsigned*)(LP.ws + OFF_BAR); { unsigned xx = xb.x; asm volatile("" : "+s"(xx)); xq.x = xx; } xcd_barrier(xq); }
        }
        phase_inproj(LP, l, smem, bid, nblk);
        { XcdBarrier xq = xb; xq.bar = (unsigned*)(LP.ws + OFF_BAR); { unsigned xx = xb.x; asm volatile("" : "+s"(xx)); xq.x = xx; } xcd_barrier(xq); }
        phase_features(LP, l, smem, bid, nblk, (unsigned*)(LP.ws + OFF_CTR) + 2 + l);
        { XcdBarrier xq = xb; xq.bar = (unsigned*)(LP.ws + OFF_BAR); { unsigned xx = xb.x; asm volatile("" : "+s"(xx)); xq.x = xx; } xcd_barrier(xq); }
        phase_scan_attn(LP, l, need_ctx, smem, bid, nblk, (unsigned*)(LP.ws + OFF_CTR) + l);
        { XcdBarrier xq = xb; xq.bar = (unsigned*)(LP.ws + OFF_BAR); { unsigned xx = xb.x; asm volatile("" : "+s"(xx)); xq.x = xx; } xcd_barrier(xq); }
        phase_rwkv_out(LP, l, nrows2, bid, nblk);
        phase_expert_convert(LP, l, bid, nblk);
        { XcdBarrier xq = xb; xq.bar = (unsigned*)(LP.ws + OFF_BAR); { unsigned xx = xb.x; asm volatile("" : "+s"(xx)); xq.x = xx; } xcd_barrier(xq); }
        {
            const P p = LP;
            const float* xlat = (l == 0) ? p.x : p.out;
            const float* xctx = (l == 0) ? p.ctx : (const float*)(p.ws + OFF_CTXS);
            phase_outproj(p, l, nrows2, xlat, xctx, smem, bid, nblk);
        }
        { XcdBarrier xq = xb; xq.bar = (unsigned*)(LP.ws + OFF_BAR); { unsigned xx = xb.x; asm volatile("" : "+s"(xx)); xq.x = xx; } xcd_barrier(xq); }
        {
            const P p = LP;
            phase_normmod<true>((const float*)(p.ws + OFF_XB), (const float*)(p.ws + OFF_CTXS), p.norm_ffn + l * D, (const float*)(p.ws + OFF_MOD) + (size_t)l * 5 * 6144, 3, 4, (bf16_t*)(p.ws + OFF_H), nrows2, bid, nblk);
        }
        { XcdBarrier xq = xb; xq.bar = (unsigned*)(LP.ws + OFF_BAR); { unsigned xx = xb.x; asm volatile("" : "+s"(xx)); xq.x = xx; } xcd_barrier(xq); }
        phase_scores(LP, l, nrows2, smem, bid, nblk);
        { XcdBarrier xq = xb; xq.bar = (unsigned*)(LP.ws + OFF_BAR); { unsigned xx = xb.x; asm volatile("" : "+s"(xx)); xq.x = xx; } xcd_barrier(xq); }
        phase_peer(LP, l, nrows2, smem, bid, nblk);
        if (l == 0) { XcdBarrier xq = xb; xq.bar = (unsigned*)(LP.ws + OFF_BAR); { unsigned xx = xb.x; asm volatile("" : "+s"(xx)); xq.x = xx; } xcd_barrier(xq); }
    }
}

}

extern "C" void kernel_launch(void* const* d_in, const int* in_sizes, int n_in, void* d_out, int out_size, void* d_ws, size_t ws_size,
                              hipStream_t stream) {
    static int grid_blocks = 0;
    if (grid_blocks == 0) {
        if (n_in != 28 || ws_size < WS_END2) { fprintf(stderr, "kernel_launch: unexpected n_in %d or ws_size %zu (need %zu)\n", n_in, ws_size, (size_t)WS_END2); grid_blocks = -1; return; }
        int dev = 0, cus = 0, per_cu = 0;
        hipGetDevice(&dev);
        hipDeviceGetAttribute(&cus, hipDeviceAttributeMultiprocessorCount, dev);
        hipFuncSetAttribute((const void*)k_mega, hipFuncAttributeMaxDynamicSharedMemorySize, MEGA_SMEM);
        hipOccupancyMaxActiveBlocksPerMultiprocessor(&per_cu, (const void*)k_mega, NTHR, MEGA_SMEM);
        if (per_cu < 1) { fprintf(stderr, "kernel_launch: occupancy query returned %d\n", per_cu); grid_blocks = -1; return; }
        if (per_cu > 2) per_cu = 2;
        grid_blocks = cus * per_cu;
    }
    if (grid_blocks < 0) return;
    P p{};
    const float** f = (const float**)&p;
    for (int i = 0; i < 28; i++) f[i] = (const float*)d_in[i];
    p.out = (float*)d_out;
    p.ws = (char*)d_ws;
    hipMemsetAsync((char*)d_ws + OFF_CTR, 0, CTL_BYTES, stream);
    void* args[] = {&p};
    hipError_t e = hipLaunchCooperativeKernel((const void*)k_mega, dim3(grid_blocks), dim3(NTHR), args, MEGA_SMEM, stream);
    if (e != hipSuccess) fprintf(stderr, "cooperative launch failed: %s (grid %d)\n", hipGetErrorString(e), grid_blocks);
}
static_assert(WS_END2 <= 536870912ull, "workspace too large");
```
